# Optimizing an MI355X kernel written in HIP

```python
import jax, jax.numpy as jnp
from jax import lax
import numpy as np

D_MODEL = 1024
BATCH = 16
SEQ = 2048
DEPTH = 4

GRID_W = 64
CTX_LEN = 256
ROPE_BASE = 10000.0
EPS = 1e-6
NEG = -1e30
BLOCK = 128

FOURIER_WIDTH = D_MODEL // 4
FOURIER_GROUPS = 4
FOURIER_GROUP_DIM = FOURIER_WIDTH // FOURIER_GROUPS

MLA_HEADS = D_MODEL // 128
MLA_NOPE = 64
MLA_ROPE = 32
MLA_V = 64
MLA_QK_DIM = MLA_NOPE + MLA_ROPE
MLA_Q_RANK = D_MODEL // 4
MLA_KV_RANK = D_MODEL // 8

SWA_Q_HEADS = D_MODEL // 256
SWA_KV_HEADS = 2
SWA_HEAD_DIM = 64
SWA_WINDOW = 128

MIX_WIDTH = FOURIER_WIDTH + MLA_HEADS * MLA_V + SWA_Q_HEADS * SWA_HEAD_DIM
IN_SPLITS = (FOURIER_WIDTH, MLA_Q_RANK, MLA_KV_RANK, MLA_ROPE,
             SWA_Q_HEADS * SWA_HEAD_DIM, SWA_KV_HEADS * SWA_HEAD_DIM, SWA_KV_HEADS * SWA_HEAD_DIM)
IN_WIDTH = sum(IN_SPLITS)
D_FF = 2816
N_MOD = 9

kernel_name = "hybrid_fourier_mla_swa_macaron_dit"


def rms_norm(x, g):
    xf = x.astype(jnp.float32)
    y = xf * lax.rsqrt(jnp.mean(xf * xf, axis=-1, keepdims=True) + EPS)
    return (y * g.astype(jnp.float32)).astype(x.dtype)


def modulation(cvec, w, b):
    m = jax.nn.silu(cvec) @ w + b
    return m.reshape(cvec.shape[0], N_MOD, D_MODEL)


def modulate(x, shift, scale):
    return x * (1.0 + scale[:, None, :]) + shift[:, None, :]


def swiglu(x, w1, w3, w2):
    return (jax.nn.silu(x @ w1) * (x @ w3)) @ w2


def macaron_half(h, m, i, g, w1, w3, w2):
    y = swiglu(modulate(rms_norm(h, g), m[:, 3 * i], m[:, 3 * i + 1]), w1, w3, w2)
    return h + 0.5 * m[:, 3 * i + 2, None, :] * y


def split_cols(u, widths):
    offs = [int(o) for o in np.cumsum(widths)[:-1]]
    return jnp.split(u, offs, axis=-1)


def axial_rope_tables(rows, dim):
    row = jnp.repeat(jnp.arange(rows, dtype=jnp.float32), GRID_W)
    col = jnp.tile(jnp.arange(GRID_W, dtype=jnp.float32), rows)
    axis_dim = dim // 2
    inv = ROPE_BASE ** (-jnp.arange(0, axis_dim, 2, dtype=jnp.float32) / axis_dim)
    ang = jnp.concatenate([row[:, None] * inv, col[:, None] * inv], axis=-1)
    return jnp.cos(ang), jnp.sin(ang)


def apply_rope(x, cos, sin):
    xf = x.astype(jnp.float32).reshape(*x.shape[:-1], x.shape[-1] // 2, 2)
    x1, x2 = xf[..., 0], xf[..., 1]
    cb, sb = cos[None, :, None, :], sin[None, :, None, :]
    y = jnp.stack([x1 * cb - x2 * sb, x1 * sb + x2 * cb], axis=-1).reshape(x.shape)
    return y.astype(x.dtype)


def fourier_mix(u):
    B, n, _ = u.shape
    z = u.astype(jnp.float32).reshape(B, n, FOURIER_GROUPS, FOURIER_GROUP_DIM)
    y = jnp.fft.fft2(z, axes=(1, 3), norm="ortho").real
    return y.reshape(B, n, FOURIER_WIDTH).astype(u.dtype)


def mla_queries(u_cq, g_cq, w_uq, g_mq):
    B, n, _ = u_cq.shape
    q = (rms_norm(u_cq, g_cq) @ w_uq).reshape(B, n, MLA_HEADS, MLA_QK_DIM)
    return rms_norm(q, g_mq)


def mla_keys_values(u_ckv, u_kr, g_ckv, w_ukv, g_mk):
    B, n, _ = u_ckv.shape
    kv = (rms_norm(u_ckv, g_ckv) @ w_ukv).reshape(B, n, MLA_HEADS, MLA_NOPE + MLA_V)
    k_nope, v = kv[..., :MLA_NOPE], kv[..., MLA_NOPE:]
    k_rope = jnp.broadcast_to(u_kr[:, :, None, :], (B, n, MLA_HEADS, MLA_ROPE))
    k = rms_norm(jnp.concatenate([k_nope, k_rope], axis=-1), g_mk)
    return k, v


def rope_tail(t, cos, sin):
    return jnp.concatenate([t[..., :MLA_NOPE], apply_rope(t[..., MLA_NOPE:], cos, sin)], axis=-1)


def context_attention(q, k, v, sink):
    s = jnp.einsum('bqhgd,bkhd->bhgqk', q, k).astype(jnp.float32) * (q.shape[-1] ** -0.5)
    if sink is None:
        p = jax.nn.softmax(s, axis=-1)
    else:
        sl = jnp.broadcast_to(sink.astype(jnp.float32)[None, :, :, None, None], s.shape[:-1] + (1,))
        p = jax.nn.softmax(jnp.concatenate([sl, s], axis=-1), axis=-1)[..., 1:]
    return jnp.einsum('bhgqk,bkhd->bqhgd', p.astype(v.dtype), v)


def dense_joint_attention(q, k, v, k_ctx, v_ctx):
    B, S, H, Dk = q.shape
    nb = S // BLOCK
    k_all = jnp.concatenate([k_ctx, k], axis=1)
    v_all = jnp.concatenate([v_ctx, v], axis=1)
    qb = jnp.moveaxis(q.reshape(B, nb, BLOCK, H, Dk), 1, 0)

    def block(qblk):
        s = jnp.einsum('bqhd,bkhd->bhqk', qblk, k_all).astype(jnp.float32) * (Dk ** -0.5)
        p = jax.nn.softmax(s, axis=-1)
        return jnp.einsum('bhqk,bkhd->bqhd', p.astype(v_all.dtype), v_all)

    o = lax.map(block, qb)
    return jnp.moveaxis(o, 0, 1).reshape(B, S, H, v.shape[-1])


def banded_window_attention(q, k, v, k_ctx, v_ctx, sink):
    B, S, Hq, D = q.shape
    Hkv = k.shape[2]
    G = Hq // Hkv
    nb = S // BLOCK
    C = k_ctx.shape[1]
    qb = q.reshape(B, nb, BLOCK, Hkv, G, D)

    def neighbours(t):
        tb = jnp.pad(t, ((0, 0), (BLOCK, BLOCK), (0, 0), (0, 0))).reshape(B, nb + 2, BLOCK, Hkv, t.shape[-1])
        return jnp.concatenate([tb[:, :-2], tb[:, 1:-1], tb[:, 2:]], axis=2)

    kb, vb = neighbours(k), neighbours(v)
    q_pos = jnp.arange(S).reshape(nb, BLOCK)
    k_pos = (jnp.arange(nb)[:, None] - 1) * BLOCK + jnp.arange(3 * BLOCK)[None, :]
    kp = k_pos[:, None, :]
    valid = (jnp.abs(q_pos[:, :, None] - kp) <= SWA_WINDOW) & (kp >= 0) & (kp < S)
    scale = D ** -0.5
    s_loc = jnp.einsum('bnqhgd,bnkhd->bnhgqk', qb, kb).astype(jnp.float32) * scale
    s_loc = jnp.where(valid[None, :, None, None], s_loc, NEG)
    s_ctx = jnp.einsum('bnqhgd,bchd->bnhgqc', qb, k_ctx).astype(jnp.float32) * scale
    sl = jnp.broadcast_to(sink.reshape(Hkv, G).astype(jnp.float32)[None, None, :, :, None, None],
                          s_ctx.shape[:-1] + (1,))
    p = jax.nn.softmax(jnp.concatenate([sl, s_ctx, s_loc], axis=-1), axis=-1).astype(v.dtype)
    o = (jnp.einsum('bnhgqc,bchd->bnqhgd', p[..., 1:1 + C], v_ctx)
         + jnp.einsum('bnhgqk,bnkhd->bnqhgd', p[..., 1 + C:], vb))
    return o.reshape(B, S, Hq, D)


def token_mixing(n, nc, w_in, g_cq, w_uq, g_ckv, w_ukv, g_mq, g_mk, g_sq, g_sk, sink, w_out,
                 cos_m, sin_m, cos_s, sin_s, with_ctx_out):
    B, S, _ = n.shape
    C = nc.shape[1]
    G = SWA_Q_HEADS // SWA_KV_HEADS
    f_in, u_cq, u_ckv, u_kr, u_sq, u_sk, u_sv = split_cols(n @ w_in, IN_SPLITS)
    fc_in, uc_cq, uc_ckv, uc_kr, uc_sq, uc_sk, uc_sv = split_cols(nc @ w_in, IN_SPLITS)

    cmk, cmv = mla_keys_values(uc_ckv, uc_kr, g_ckv, w_ukv, g_mk)
    csk = rms_norm(uc_sk.reshape(B, C, SWA_KV_HEADS, SWA_HEAD_DIM), g_sk)
    csv = uc_sv.reshape(B, C, SWA_KV_HEADS, SWA_HEAD_DIM)

    mq = rope_tail(mla_queries(u_cq, g_cq, w_uq, g_mq), cos_m, sin_m)
    mk, mv = mla_keys_values(u_ckv, u_kr, g_ckv, w_ukv, g_mk)
    mk = rope_tail(mk, cos_m, sin_m)
    a = dense_joint_attention(mq, mk, mv, cmk, cmv)

    sq = apply_rope(rms_norm(u_sq.reshape(B, S, SWA_Q_HEADS, SWA_HEAD_DIM), g_sq), cos_s, sin_s)
    sk = apply_rope(rms_norm(u_sk.reshape(B, S, SWA_KV_HEADS, SWA_HEAD_DIM), g_sk), cos_s, sin_s)
    sv = u_sv.reshape(B, S, SWA_KV_HEADS, SWA_HEAD_DIM)
    w = banded_window_attention(sq, sk, sv, csk, csv, sink)

    out = jnp.concatenate([fourier_mix(f_in), a.reshape(B, S, -1), w.reshape(B, S, -1)], axis=-1) @ w_out
    if not with_ctx_out:
        return out, None

    cmq = mla_queries(uc_cq, g_cq, w_uq, g_mq)[:, :, :, None, :]
    ac = context_attention(cmq, cmk, cmv, None)
    csq = rms_norm(uc_sq.reshape(B, C, SWA_Q_HEADS, SWA_HEAD_DIM), g_sq).reshape(B, C, SWA_KV_HEADS, G, SWA_HEAD_DIM)
    wc = context_attention(csq, csk, csv, sink.reshape(SWA_KV_HEADS, G))
    out_c = jnp.concatenate([fourier_mix(fc_in), ac.reshape(B, C, -1), wc.reshape(B, C, -1)], axis=-1) @ w_out
    return out, out_c


def setup_inputs(seed: int = 0) -> dict:
    key = jax.random.key(seed)
    ks = jax.random.split(key, 26)
    nrm = jax.random.normal
    L, D = DEPTH, D_MODEL
    f32 = jnp.float32

    def gain(k, shape):
        return 1.0 + 0.05 * nrm(k, shape, f32)

    return {
        "x": nrm(ks[0], (BATCH, SEQ, D), f32),
        "c": nrm(ks[1], (BATCH, D), f32),
        "ctx": nrm(ks[2], (BATCH, CTX_LEN, D), f32),
        "c_ctx": nrm(ks[3], (D,), f32),
        "w_ada": nrm(ks[4], (L, D, N_MOD * D), f32) * (0.5 * D ** -0.5),
        "b_ada": 0.02 * nrm(ks[5], (L, N_MOD * D), f32),
        "g_ffn1": gain(ks[6], (L, D)),
        "w1_ffn1": nrm(ks[7], (L, D, D_FF), f32) * D ** -0.5,
        "w3_ffn1": nrm(ks[8], (L, D, D_FF), f32) * D ** -0.5,
        "w2_ffn1": nrm(ks[9], (L, D_FF, D), f32) * D_FF ** -0.5,
        "g_mix": gain(ks[10], (L, D)),
        "w_in": nrm(ks[11], (L, D, IN_WIDTH), f32) * D ** -0.5,
        "g_cq": gain(ks[12], (L, MLA_Q_RANK)),
        "w_uq": nrm(ks[13], (L, MLA_Q_RANK, MLA_HEADS * MLA_QK_DIM), f32) * MLA_Q_RANK ** -0.5,
        "g_ckv": gain(ks[14], (L, MLA_KV_RANK)),
        "w_ukv": nrm(ks[15], (L, MLA_KV_RANK, MLA_HEADS * (MLA_NOPE + MLA_V)), f32) * MLA_KV_RANK ** -0.5,
        "g_mla_q": gain(ks[16], (L, MLA_QK_DIM)),
        "g_mla_k": gain(ks[17], (L, MLA_QK_DIM)),
        "g_swa_q": gain(ks[18], (L, SWA_HEAD_DIM)),
        "g_swa_k": gain(ks[19], (L, SWA_HEAD_DIM)),
        "sink": 0.5 * nrm(ks[20], (L, SWA_Q_HEADS), f32),
        "w_out": nrm(ks[21], (L, MIX_WIDTH, D), f32) * MIX_WIDTH ** -0.5,
        "g_ffn2": gain(ks[22], (L, D)),
        "w1_ffn2": nrm(ks[23], (L, D, D_FF), f32) * D ** -0.5,
        "w3_ffn2": nrm(ks[24], (L, D, D_FF), f32) * D ** -0.5,
        "w2_ffn2": nrm(ks[25], (L, D_FF, D), f32) * D_FF ** -0.5,
    }


def reference(x, c, ctx, c_ctx, w_ada, b_ada, g_ffn1, w1_ffn1, w3_ffn1, w2_ffn1, g_mix, w_in,
              g_cq, w_uq, g_ckv, w_ukv, g_mla_q, g_mla_k, g_swa_q, g_swa_k, sink, w_out,
              g_ffn2, w1_ffn2, w3_ffn2, w2_ffn2):
    rows = x.shape[1] // GRID_W
    cos_m, sin_m = axial_rope_tables(rows, MLA_ROPE)
    cos_s, sin_s = axial_rope_tables(rows, SWA_HEAD_DIM)
    h, hc = x, ctx
    for l in range(DEPTH):
        last = l == DEPTH - 1
        m = modulation(c, w_ada[l], b_ada[l])
        mc = modulation(c_ctx[None, :], w_ada[l], b_ada[l])
        h = macaron_half(h, m, 0, g_ffn1[l], w1_ffn1[l], w3_ffn1[l], w2_ffn1[l])
        hc = macaron_half(hc, mc, 0, g_ffn1[l], w1_ffn1[l], w3_ffn1[l], w2_ffn1[l])
        n = modulate(rms_norm(h, g_mix[l]), m[:, 3], m[:, 4])
        nc = modulate(rms_norm(hc, g_mix[l]), mc[:, 3], mc[:, 4])
        out, out_c = token_mixing(n, nc, w_in[l], g_cq[l], w_uq[l], g_ckv[l], w_ukv[l],
                                  g_mla_q[l], g_mla_k[l], g_swa_q[l], g_swa_k[l], sink[l], w_out[l],
                                  cos_m, sin_m, cos_s, sin_s, not last)
        h = h + m[:, 5, None, :] * out
        h = macaron_half(h, m, 2, g_ffn2[l], w1_ffn2[l], w3_ffn2[l], w2_ffn2[l])
        if not last:
            hc = hc + mc[:, 5, None, :] * out_c
            hc = macaron_half(hc, mc, 2, g_ffn2[l], w1_ffn2[l], w3_ffn2[l], w2_ffn2[l])
    return h
```

```cpp
#include <hip/hip_runtime.h>
#include <hip/hip_cooperative_groups.h>
#include <cstdio>
namespace cg = cooperative_groups;

#define LAS __attribute__((address_space(3)))
#define GAS __attribute__((address_space(1)))
#define DI __device__ __forceinline__
typedef unsigned short bf16_t;
typedef short bf16x8 __attribute__((ext_vector_type(8)));
typedef float f32x4 __attribute__((ext_vector_type(4)));
typedef float f32x2 __attribute__((ext_vector_type(2)));
typedef float f32x16 __attribute__((ext_vector_type(16)));
typedef unsigned u32x2 __attribute__((ext_vector_type(2)));
typedef unsigned u32x4 __attribute__((ext_vector_type(4)));
typedef __bf16 bf16x2_t __attribute__((ext_vector_type(2)));

constexpr int D = 1024, NB = 16, SEQ = 2048, CTXN = 256, TL = NB * SEQ, TC = NB * CTXN, T = TL + TC, DFF = 2816, NMODW = 9216;
constexpr float EPS = 1e-6f;
constexpr int LDS_BYTES = 131072 + 16;
#ifndef REP_ATTN
#define REP_ATTN 1
#endif
#ifndef REP_UP
#define REP_UP 1
#endif
#ifndef REP_NORM
#define REP_NORM 1
#endif
#ifndef REP_PREP
#define REP_PREP 1
#endif
#ifndef REP_INP
#define REP_INP 1
#endif
#ifndef REP_QKV
#define REP_QKV 1
#endif
#ifndef REP_DOWN
#define REP_DOWN 1
#endif
#ifndef REP_OUT
#define REP_OUT 1
#endif
#ifndef EXTRA_SYNC
#define EXTRA_SYNC 0
#endif

struct Params {
  const float *x, *c, *ctx, *c_ctx, *w_ada, *b_ada, *g_ffn1, *w1_ffn1, *w3_ffn1, *w2_ffn1, *g_mix, *w_in, *g_cq, *w_uq, *g_ckv, *w_ukv,
      *g_mla_q, *g_mla_k, *g_swa_q, *g_swa_k, *sink, *w_out, *g_ffn2, *w1_ffn2, *w3_ffn2, *w2_ffn2;
  float* out;
  unsigned char* ws;
};

constexpr size_t OFF_HCTX = 0;
constexpr size_t OFF_XN = OFF_HCTX + (size_t)TC * D * 4;
constexpr size_t OFF_HID = OFF_XN + (size_t)T * D * 2;
constexpr size_t OFF_ZTL = OFF_HID;
constexpr size_t OFF_ZTC = OFF_ZTL + (size_t)4096 * 4096 * 2;
constexpr size_t OFF_LAT = OFF_ZTC + (size_t)4096 * 512 * 2;
constexpr size_t OFF_Q = OFF_LAT + (size_t)T * 384 * 2;
constexpr size_t OFF_K = OFF_Q + (size_t)T * 768 * 2;
constexpr size_t OFF_HID_END = OFF_HID + (size_t)T * DFF * 2;
static_assert(OFF_K + (size_t)T * 768 * 2 <= OFF_HID_END, "alias overflow");
constexpr size_t OFF_V = OFF_HID_END;
constexpr size_t OFF_SQ = OFF_V + (size_t)T * 512 * 2;
constexpr size_t OFF_SK = OFF_SQ + (size_t)T * 256 * 2;
constexpr size_t OFF_SV = OFF_SK + (size_t)T * 128 * 2;
constexpr size_t OFF_KR = OFF_SV + (size_t)T * 128 * 2;
constexpr size_t OFF_SSQ_CQ = OFF_KR + (size_t)T * 32 * 4;
constexpr size_t OFF_SSQ_CKV = OFF_SSQ_CQ + (size_t)T * 4 * 4;
constexpr size_t OFF_SSQ_KR = OFF_SSQ_CKV + (size_t)T * 2 * 4;
constexpr size_t OFF_SSQ_Q = OFF_SSQ_KR + (size_t)T * 4;
constexpr size_t OFF_MOD = OFF_SSQ_Q + (size_t)T * 16 * 4;
constexpr size_t OFF_ROPE = OFF_MOD + (size_t)4 * 17 * NMODW * 4;
constexpr size_t OFF_DFTL = OFF_ROPE + (size_t)2048 * 96 * 4;
constexpr size_t OFF_DFTC = OFF_DFTL + (size_t)2048 * 4096 * 2;
constexpr size_t OFF_W = OFF_DFTC + (size_t)256 * 512 * 2;
constexpr size_t WO_UP1 = 0;
constexpr size_t WO_DN1 = WO_UP1 + (size_t)5632 * 1024 * 2;
constexpr size_t WO_UP2 = WO_DN1 + (size_t)1024 * 2816 * 2;
constexpr size_t WO_DN2 = WO_UP2 + (size_t)5632 * 1024 * 2;
constexpr size_t WO_INB = WO_DN2 + (size_t)1024 * 2816 * 2;
constexpr size_t WO_AZ = WO_INB + (size_t)1024 * 1024 * 2;
constexpr size_t WO_QKV = WO_AZ + (size_t)512 * 1024 * 2;
constexpr size_t WO_OUT = WO_QKV + (size_t)2048 * 384 * 2;
constexpr size_t W_LAYER = WO_OUT + (size_t)1024 * 1024 * 2;
constexpr size_t OFF_PCTX = OFF_W + 4 * W_LAYER;
constexpr size_t OFF_BAR = OFF_PCTX + (size_t)TC * D * 4;
constexpr size_t BAR_BYTES = 3456 * 4;
constexpr size_t WS_TOTAL = OFF_BAR + BAR_BYTES;
static_assert(WS_TOTAL < (size_t)615 * 1000 * 1000, "workspace too large");

DI unsigned pk(float a, float b) { f32x2 v = {a, b}; return __builtin_bit_cast(unsigned, __builtin_convertvector(v, bf16x2_t)); }
DI void st4(bf16_t* p, f32x4 v) { u32x2 o = {pk(v[0], v[1]), pk(v[2], v[3])}; *(GAS u32x2*)p = o; }
DI float fexp2(float x) { return __builtin_amdgcn_exp2f(x); }

namespace pg8 {
constexpr int BM = 256, BK = 64, HALF = 128, HTB = HALF * BK * 2, NXCD = 8, WGM = 8;
DI int lds_byte(int r, int c) { const int st = (r >> 4) * 2 + (c >> 5), rr = r & 15, cc = c & 31, ob = rr * 64 + cc * 2; return st * 1024 + (ob ^ (((ob >> 9) & 1) << 5)); }
DI void stage_rc(int b, int& R, int& C) { const int st = b / 1024, sb = b % 1024, swz = sb ^ (((sb >> 9) & 1) << 5); R = (st >> 1) * 16 + swz / 64; C = (st & 1) * 32 + (swz % 64) / 2; }
struct Unit { int pm, pn; };
struct Gemm { const bf16_t* A; const bf16_t* Bt; int M, N, K, lda, ldb, permB; };
struct StaticOrder {
  int nM, nN, nwg, G, c, pm_off;
  DI void init(int M, int N, int G_, int c_, int pm_off_ = 0) { nM = M / BM; nN = N / BM; nwg = nM * nN; G = G_; c = c_; pm_off = pm_off_; }
  DI bool next(int i, Unit& u) const {
    const long L = (long)i * G + c; if (L >= nwg) return false;
    int wgid = (int)L; { const int q = nwg / NXCD, r = nwg % NXCD, xcd = wgid % NXCD, off = wgid / NXCD; wgid = (xcd < r ? xcd * (q + 1) : r * (q + 1) + (xcd - r) * q) + off; }
    const int nig = WGM * nN, gid = wgid / nig, fm = gid * WGM, gsz = (nM - fm) < WGM ? (nM - fm) : WGM;
    u.pm = pm_off + fm + ((wgid % nig) % gsz); u.pn = (wgid % nig) / gsz; return true;
  }
};
template <class Epi, class Sched>
DI void gemm_phase(LAS unsigned char* lds, const int tid, const Gemm g, const Sched& S, const Epi& E) {
  const int wid = __builtin_amdgcn_readfirstlane(tid >> 6), lane = tid & 63, wr = wid >> 2, wc = wid & 3, fr = lane & 15, fq = lane >> 4;
  const int K = g.K, nt = K / BK;
  unsigned voffA[2], voffB[2];
#pragma unroll
  for (int i = 0; i < 2; ++i) { int R, C; stage_rc(tid * 16 + i * 8192, R, C); voffA[i] = (unsigned)(R * g.lda + C) * 2u;
    const int r5 = R & 31, Rb = g.permB ? ((R & ~31) + 8 * ((r5 & 15) >> 2) + 4 * (r5 >> 4) + (r5 & 3)) : R; voffB[i] = (unsigned)(Rb * g.ldb + C) * 2u; }
  const size_t kstep = (size_t)(BK * 2);
  const size_t hstepA = (size_t)HALF * g.lda * 2, hstepB = (size_t)HALF * g.ldb * 2;
  const size_t tstepA = 2 * hstepA, tstepB = 2 * hstepB;
  const unsigned ldsw = (unsigned)wid * 1024u;
  const int aoff = lds_byte(wr * 64 + fr, fq * 8), boff = lds_byte(wc * 32 + fr, fq * 8);
#define PG8_SA(b, h) (((b) * 2 + (h)) * HTB)
#define PG8_SB(b, h) ((4 + (b) * 2 + (h)) * HTB)
#define PG8_STAGE(bufoff, gbase, voff) do { _Pragma("unroll") for (int _i = 0; _i < 2; ++_i) \
    __builtin_amdgcn_global_load_lds((const unsigned*)((const char*)(gbase) + (voff)[_i]), (LAS unsigned*)(lds + (bufoff) + ldsw + _i * 8192), 16, 0, 0); } while (0)
#define PG8_LDA(dst, b, h) do { _Pragma("unroll") for (int m = 0; m < 4; ++m) _Pragma("unroll") for (int k = 0; k < 2; ++k) dst[m][k] = *(const LAS bf16x8*)(lds + PG8_SA(b, h) + aoff + m * 2048 + k * 1024); } while (0)
#define PG8_LDB(dst, b, h) do { _Pragma("unroll") for (int n = 0; n < 2; ++n) _Pragma("unroll") for (int k = 0; k < 2; ++k) dst[n][k] = *(const LAS bf16x8*)(lds + PG8_SB(b, h) + boff + n * 2048 + k * 1024); } while (0)
#define PG8_MMA(ai, bj, At, Bt) do { __builtin_amdgcn_s_setprio(1); _Pragma("unroll") for (int m = 0; m < 4; ++m) _Pragma("unroll") for (int n = 0; n < 2; ++n) _Pragma("unroll") for (int k = 0; k < 2; ++k) \
    acc[ai][bj][m][n] = __builtin_amdgcn_mfma_f32_16x16x32_bf16(Bt[n][k], At[m][k], acc[ai][bj][m][n], 0, 0, 0); __builtin_amdgcn_s_setprio(0); } while (0)
#define PG8_WAIT_V(n) asm volatile("s_waitcnt vmcnt(" #n ")" ::: "memory")
#define PG8_WAIT_L(n) asm volatile("s_waitcnt lgkmcnt(" #n ")" ::: "memory")
#define PG8_BAR __builtin_amdgcn_s_barrier()
#define PG8_SCHED __builtin_amdgcn_sched_barrier(0)
  Unit cur, nxt; int ui = 0;
  if (!S.next(0, cur)) return;
  f32x4 acc[2][2][4][2];
#pragma unroll
  for (int a = 0; a < 2; ++a)
#pragma unroll
    for (int b = 0; b < 2; ++b)
#pragma unroll
      for (int m = 0; m < 4; ++m)
#pragma unroll
        for (int n = 0; n < 2; ++n) acc[a][b][m][n] = (f32x4){0.f, 0.f, 0.f, 0.f};
  bf16x8 At[4][2], B0[2][2], B1[2][2];
  const char* cA = (const char*)g.A + (size_t)cur.pm * tstepA; const char* cB = (const char*)g.Bt + (size_t)cur.pn * tstepB;
  PG8_STAGE(PG8_SB(0, 0), cB, voffB); PG8_STAGE(PG8_SA(0, 0), cA, voffA); PG8_STAGE(PG8_SB(0, 1), cB + hstepB, voffB); PG8_STAGE(PG8_SA(0, 1), cA + hstepA, voffA);
  if (wr == 1) PG8_BAR;
  PG8_WAIT_V(4); PG8_BAR;
  PG8_STAGE(PG8_SB(1, 0), cB + kstep, voffB); PG8_STAGE(PG8_SA(1, 0), cA + kstep, voffA); PG8_STAGE(PG8_SB(1, 1), cB + hstepB + kstep, voffB);
  PG8_WAIT_V(6); PG8_BAR;
  for (;;) {
    const bool has_next = S.next(ui + 1, nxt);
    const char* nA = has_next ? (const char*)g.A + (size_t)nxt.pm * tstepA : cA; const char* nB = has_next ? (const char*)g.Bt + (size_t)nxt.pn * tstepB : cB;
#pragma unroll 1
    for (int t = 0; t < nt; t += 2) {
      const bool last = (t == nt - 2);
      const char* a1 = cA + (size_t)(t + 1) * kstep;
      const char* a2 = last ? nA : cA + (size_t)(t + 2) * kstep; const char* b2 = last ? nB : cB + (size_t)(t + 2) * kstep;
      const char* a3 = a2 + kstep; const char* b3 = b2 + kstep;
      PG8_LDB(B0, 0, 0); PG8_SCHED; PG8_LDA(At, 0, 0); PG8_STAGE(PG8_SA(1, 1), a1 + hstepA, voffA);
      PG8_WAIT_L(8); PG8_BAR; PG8_WAIT_L(0); PG8_MMA(0, 0, At, B0); PG8_BAR; PG8_SCHED;
      PG8_LDB(B1, 0, 1); PG8_STAGE(PG8_SB(0, 0), b2, voffB);
      PG8_BAR; PG8_WAIT_L(0); PG8_MMA(0, 1, At, B1); PG8_BAR;
      PG8_LDA(At, 0, 1); PG8_STAGE(PG8_SA(0, 0), a2, voffA);
      PG8_BAR; PG8_WAIT_L(0); PG8_MMA(1, 0, At, B0); PG8_BAR; PG8_SCHED;
      PG8_STAGE(PG8_SB(0, 1), b2 + hstepB, voffB);
      PG8_WAIT_V(6); PG8_BAR; PG8_MMA(1, 1, At, B1); PG8_BAR;
      PG8_LDB(B0, 1, 0); PG8_SCHED; PG8_LDA(At, 1, 0); PG8_STAGE(PG8_SA(0, 1), a2 + hstepA, voffA);
      PG8_WAIT_L(8); PG8_BAR; PG8_WAIT_L(0); PG8_MMA(0, 0, At, B0); PG8_BAR; PG8_SCHED;
      PG8_LDB(B1, 1, 1); PG8_STAGE(PG8_SB(1, 0), b3, voffB);
      PG8_BAR; PG8_WAIT_L(0); PG8_MMA(0, 1, At, B1); PG8_BAR;
      PG8_LDA(At, 1, 1); PG8_STAGE(PG8_SA(1, 0), a3, voffA);
      PG8_BAR; PG8_WAIT_L(0); PG8_MMA(1, 0, At, B0); PG8_BAR; PG8_SCHED;
      PG8_STAGE(PG8_SB(1, 1), b3 + hstepB, voffB);
      PG8_WAIT_V(6); PG8_BAR; PG8_MMA(1, 1, At, B1); PG8_BAR;
    }
    { int z_e = 0; asm volatile("" : "+v"(z_e)); const int lane_e = __builtin_amdgcn_mbcnt_hi(~0u, __builtin_amdgcn_mbcnt_lo(~0u, (unsigned)z_e));
      E(acc, cur, wr, wc, lane_e & 15, lane_e >> 4); }
    if (!has_next) break;
#pragma unroll
    for (int a = 0; a < 2; ++a)
#pragma unroll
      for (int b = 0; b < 2; ++b)
#pragma unroll
        for (int m = 0; m < 4; ++m)
#pragma unroll
          for (int n = 0; n < 2; ++n) acc[a][b][m][n] = (f32x4){0.f, 0.f, 0.f, 0.f};
    cur = nxt; cA = nA; cB = nB; ++ui;
  }
  PG8_WAIT_V(0);
  if (wr == 0) PG8_BAR;
  PG8_BAR;
#undef PG8_SA
#undef PG8_SB
#undef PG8_STAGE
#undef PG8_LDA
#undef PG8_LDB
#undef PG8_MMA
#undef PG8_WAIT_V
#undef PG8_WAIT_L
#undef PG8_BAR
#undef PG8_SCHED
}
}
using pg8::Unit;
typedef f32x4 AccT[2][2][4][2];

template <class Epi>
DI void run_gemm(LAS unsigned char* lds, const int tid, const bf16_t* A, const bf16_t* Bt, int M, int N, int K, const Epi& E, int G, int c, int pm_off = 0, int lda = 0, int ldb = 0, int permB = 0) {
  pg8::Gemm g{A, Bt, M, N, K, lda ? lda : K, ldb ? ldb : K, permB}; pg8::StaticOrder S; S.init(M, N, G, c, pm_off);
  pg8::gemm_phase<Epi, pg8::StaticOrder>(lds, tid, g, S, E);
}

DI void st8p(void* ub, unsigned voff, f32x4 a, f32x4 b) { u32x4 o = {pk(a[0], a[1]), pk(a[2], a[3]), pk(b[0], b[1]), pk(b[2], b[3])}; *(GAS u32x4*)((char*)ub + voff) = o; }
DI void st4p(void* ub, unsigned voff, f32x4 v) { u32x2 o = {pk(v[0], v[1]), pk(v[2], v[3])}; *(GAS u32x2*)((char*)ub + voff) = o; }
DI f32x4 ld4p(const void* ub, unsigned voff) { return *(const GAS f32x4*)((const char*)ub + voff); }
DI f32x2 ld2p(const void* ub, unsigned voff) { return *(const GAS f32x2*)((const char*)ub + voff); }
DI float ld1p(const void* ub, unsigned voff) { return *(const GAS float*)((const char*)ub + voff); }
#define ROWS_LOOP _Pragma("unroll") for (int ai = 0; ai < 2; ++ai) _Pragma("unroll") for (int m = 0; m < 4; ++m)
#define COLS_LOOP _Pragma("unroll") for (int bj = 0; bj < 2; ++bj) _Pragma("unroll") for (int n = 0; n < 2; ++n)
struct EpiUp {
  bf16_t* HID;
  DI void operator()(const AccT& acc, const Unit& u, int wr, int wc, int fr, int fq) const {
    const char* base = (const char*)(HID + (size_t)u.pm * 256 * DFF + u.pn * 128);
    const unsigned o0 = (unsigned)((wr * 64 + fr) * DFF + wc * 32 + fq * 8) * 2u;
    ROWS_LOOP {
      char* rb = (char*)base + (size_t)(ai * 128 + m * 16) * DFF * 2;
      f32x4 h[2];
#pragma unroll
      for (int n = 0; n < 2; ++n) {
        const f32x4 gt = acc[ai][0][m][n], up = acc[ai][1][m][n];
#pragma unroll
        for (int e = 0; e < 4; ++e) h[n][e] = gt[e] * __builtin_amdgcn_rcpf(1.f + __expf(-gt[e])) * up[e];
      }
      u32x4 o = {pk(h[0][0], h[0][1]), pk(h[0][2], h[0][3]), pk(h[1][0], h[1][1]), pk(h[1][2], h[1][3])};
      *(GAS u32x4*)(rb + o0) = o;
    }
  }
};
struct EpiRes {
  float* out; float* hctx; const float* gate; float coef; float* pctx; const float* hsrc;
  DI void operator()(const AccT& acc, const Unit& u, int wr, int wc, int fr, int fq) const {
    const int b = u.pm < 128 ? (u.pm >> 3) : 16;
    const unsigned c0 = (unsigned)(wc * 32 + fq * 4) * 4u, o0 = (unsigned)((wr * 64 + fr) * D) * 4u + c0;
    if (pctx) {
      char* pb = (char*)(pctx + (size_t)(u.pm - 128) * 256 * D + u.pn * 256);
      ROWS_LOOP {
        char* rb = pb + (size_t)(ai * 128 + m * 16) * D * 4;
        COLS_LOOP *(GAS f32x4*)(rb + (bj * 128 + n * 16) * 4 + o0) = acc[ai][bj][m][n];
      }
      return;
    }
    char* hb = (char*)((u.pm < 128 ? out + (size_t)u.pm * 256 * D : hctx + (size_t)(u.pm - 128) * 256 * D) + u.pn * 256);
    const char* hs = (const char*)((u.pm < 128 ? hsrc + (size_t)u.pm * 256 * D : hctx + (size_t)(u.pm - 128) * 256 * D) + u.pn * 256);
    const char* gp = (const char*)(gate + (size_t)b * NMODW + u.pn * 256);
    f32x4 gv[2][2];
    COLS_LOOP gv[bj][n] = ld4p(gp + (bj * 128 + n * 16) * 4, c0);
    __builtin_amdgcn_sched_barrier(0);
    COLS_LOOP gv[bj][n] = gv[bj][n] * coef;
#pragma unroll
    for (int ai = 0; ai < 2; ++ai) {
      f32x4 hv[4][2][2];
#pragma unroll
      for (int m = 0; m < 4; ++m) { const char* rs_ = hs + (size_t)(ai * 128 + m * 16) * D * 4;
        COLS_LOOP hv[m][bj][n] = *(const GAS f32x4*)(rs_ + (bj * 128 + n * 16) * 4 + o0); }
#pragma unroll
      for (int m = 0; m < 4; ++m) { char* rb = hb + (size_t)(ai * 128 + m * 16) * D * 4;
        COLS_LOOP *(GAS f32x4*)(rb + (bj * 128 + n * 16) * 4 + o0) = hv[m][bj][n] + gv[bj][n] * acc[ai][bj][m][n]; }
    }
  }
};
struct EpiZ {
  bf16_t *ZTL, *ZTC;
  DI void operator()(const AccT& acc, const Unit& u, int wr, int wc, int fr, int fq) const {
    const bool lat = u.pn < 128;
    const int ld = lat ? 4096 : 512, snoff = lat ? 2048 : 256;
    const char* base = (const char*)((lat ? ZTL + ((size_t)(u.pn >> 3) * 256 * 4096 + (u.pn & 7) * 256) : ZTC + (size_t)(u.pn - 128) * 256 * 512) + (size_t)(u.pm * 128) * ld + wr * snoff);
    const unsigned o0 = (unsigned)(fr * ld + wc * 32 + fq * 8) * 2u;
    ROWS_LOOP {
      char* rb = (char*)base + (size_t)((ai * 64 + m * 16) * ld) * 2;
#pragma unroll
      for (int bj = 0; bj < 2; ++bj) st8p(rb + bj * 256, o0, acc[ai][bj][m][0], acc[ai][bj][m][1]);
    }
  }
};
struct EpiFour {
  bf16_t* MIX; int ctx;
  DI void operator()(const AccT& acc, const Unit& u, int wr, int wc, int fr, int fq) const {
    const char* base = (const char*)(MIX + (ctx ? (size_t)(TL + u.pn * 256) : (size_t)(u.pn * 2048 + u.pm * 256)) * D);
    const unsigned o0 = (unsigned)((wr * 64 + fr) * D + wc * 32 + fq * 8) * 2u;
    ROWS_LOOP {
      char* rb = (char*)base + (size_t)(ai * 128 + m * 16) * D * 2;
#pragma unroll
      for (int bj = 0; bj < 2; ++bj) st8p(rb + bj * 256, o0, acc[ai][bj][m][0], acc[ai][bj][m][1]);
    }
  }
};
DI f32x4 rope4(f32x4 x, const void* ct, const void* st, unsigned voff) {
  const f32x2 c = ld2p(ct, voff), s = ld2p(st, voff);
  f32x4 y; y[0] = x[0] * c[0] - x[1] * s[0]; y[1] = x[0] * s[0] + x[1] * c[0]; y[2] = x[2] * c[1] - x[3] * s[1]; y[3] = x[2] * s[1] + x[3] * c[1]; return y;
}
DI float lane_ssq(const AccT& acc, int ai, int m, float sc) {
  float ss = 0.f;
#pragma unroll
  for (int bj = 0; bj < 2; ++bj)
#pragma unroll
    for (int n = 0; n < 2; ++n)
#pragma unroll
      for (int e = 0; e < 4; ++e) { const float v = acc[ai][bj][m][n][e] * sc; ss += v * v; }
  ss += __shfl_xor(ss, 16); ss += __shfl_xor(ss, 32); return ss;
}
DI f32x4 rot4(f32x4 x, f32x2 c, f32x2 s) { f32x4 y; y[0] = x[0] * c[0] - x[1] * s[0]; y[1] = x[0] * s[0] + x[1] * c[0]; y[2] = x[2] * c[1] - x[3] * s[1]; y[3] = x[2] * s[1] + x[3] * c[1]; return y; }
struct EpiInB {
  bf16_t *LAT, *SQ, *SK, *SV; float *KR, *ssq_cq, *ssq_ckv, *ssq_kr;
  const float *g_sq, *g_sk, *g_mk, *cosS, *sinS, *cosM, *sinM;
  DI void operator()(const AccT& acc, const Unit& u, int wr, int wc, int fr, int fq) const {
    const bool lat = u.pm < 128; const int pn = u.pn;
    const unsigned rowb = (unsigned)u.pm * 256u, rl0 = (unsigned)(wr * 64 + fr);
    const unsigned posb = rowb & 2047u;
    if (pn == 0 || (pn == 3 && wc < 2)) {
      const char* base = (const char*)(LAT + (size_t)rowb * 384 + (pn == 0 ? wc * 64 : 256 + wc * 64));
      const char* sb = pn == 0 ? (const char*)(ssq_cq + (size_t)rowb * 4 + wc) : (const char*)(ssq_ckv + (size_t)rowb * 2 + wc);
      const unsigned o0 = (rl0 * 384u + fq * 8) * 2u, so0 = rl0 * (pn == 0 ? 16u : 8u), sst = pn == 0 ? 16u : 8u;
      ROWS_LOOP {
        const float ss = lane_ssq(acc, ai, m, 1.f);
        char* rb = (char*)base + (size_t)(ai * 128 + m * 16) * 384 * 2;
#pragma unroll
        for (int bj = 0; bj < 2; ++bj) st8p(rb + bj * 64, o0, acc[ai][bj][m][0], acc[ai][bj][m][1]);
        if (fq == 0) *(GAS float*)((char*)sb + (size_t)(ai * 128 + m * 16) * sst + so0) = ss;
      }
    } else if (pn == 1 || (pn == 2 && wc < 2)) {
      const float* g = pn == 1 ? g_sq : g_sk; const float sc = pn == 1 ? 0.125f : 1.f;
      const unsigned ldo = pn == 1 ? 256u : 128u;
      const char* base = (const char*)((pn == 1 ? SQ + (size_t)rowb * 256 : SK + (size_t)rowb * 128) + wc * 64);
      const unsigned o0 = (rl0 * ldo + fq * 8) * 2u;
      const unsigned ro0 = (rl0 * 32u + fq * 4) * 4u;
      const char* cb = (const char*)(cosS + posb * 32), *sbp = (const char*)(sinS + posb * 32);
      f32x4 gv[2][2];
      COLS_LOOP gv[bj][n] = ld4p((const char*)g + (bj * 32 + n * 4) * 4, fq * 32u);
#pragma unroll
      for (int aim = 0; aim < 4; ++aim) { const int ai = aim >> 1, m0 = (aim & 1) * 2;
        f32x2 cc[4][2][2], sn[4][2][2];
#pragma unroll
        for (int m = m0; m < m0 + 2; ++m)
          COLS_LOOP { cc[m][bj][n] = ld2p(cb + ((ai * 128 + m * 16) * 32 + bj * 16 + n * 2) * 4, ro0); sn[m][bj][n] = ld2p(sbp + ((ai * 128 + m * 16) * 32 + bj * 16 + n * 2) * 4, ro0); }
#pragma unroll
        for (int m = m0; m < m0 + 2; ++m) {
          const float ss = lane_ssq(acc, ai, m, 1.f);
          const float rstd = rsqrtf(ss * (1.f / 64.f) + EPS);
          char* rb = (char*)base + (size_t)(ai * 128 + m * 16) * ldo * 2;
#pragma unroll
          for (int bj = 0; bj < 2; ++bj) { f32x4 y[2];
#pragma unroll
            for (int n = 0; n < 2; ++n) { const f32x4 x = acc[ai][bj][m][n] * rstd * gv[bj][n];
              y[n] = rot4(x, lat ? cc[m][bj][n] : (f32x2){1.f, 1.f}, lat ? sn[m][bj][n] : (f32x2){0.f, 0.f}) * sc; }
            st8p(rb + bj * 64, o0, y[0], y[1]); }
        }
      }
    } else if (pn == 2) {
      const char* base = (const char*)(SV + (size_t)rowb * 128 + (wc - 2) * 64);
      const unsigned o0 = (rl0 * 128u + fq * 8) * 2u;
      ROWS_LOOP {
        char* rb = (char*)base + (size_t)(ai * 128 + m * 16) * 128 * 2;
#pragma unroll
        for (int bj = 0; bj < 2; ++bj) st8p(rb + bj * 64, o0, acc[ai][bj][m][0], acc[ai][bj][m][1]);
      }
    } else if (wc == 2) {
      const char* base = (const char*)(KR + (size_t)rowb * 32);
      const char* sb = (const char*)(ssq_kr + rowb);
      const unsigned o0 = (rl0 * 32u + fq * 8) * 4u, ro0 = (rl0 * 16u + fq * 4) * 4u;
      const char* cb = (const char*)(cosM + posb * 16), *sbp = (const char*)(sinM + posb * 16);
      f32x4 gv[2];
#pragma unroll
      for (int n = 0; n < 2; ++n) gv[n] = ld4p((const char*)(g_mk + 64) + n * 16, fq * 32u);
#pragma unroll
      for (int aim = 0; aim < 4; ++aim) { const int ai = aim >> 1, m0 = (aim & 1) * 2;
        f32x2 cc[4][2], sn[4][2];
#pragma unroll
        for (int m = m0; m < m0 + 2; ++m)
#pragma unroll
          for (int n = 0; n < 2; ++n) { cc[m][n] = ld2p(cb + ((ai * 128 + m * 16) * 16 + n * 2) * 4, ro0); sn[m][n] = ld2p(sbp + ((ai * 128 + m * 16) * 16 + n * 2) * 4, ro0); }
#pragma unroll
        for (int m = m0; m < m0 + 2; ++m) {
          const float ss = lane_ssq(acc, ai, m, 1.f);
          if (fq == 0) *(GAS float*)((char*)sb + (size_t)(ai * 128 + m * 16) * 4 + rl0 * 4u) = ss;
          char* rb = (char*)base + (size_t)(ai * 128 + m * 16) * 32 * 4;
#pragma unroll
          for (int n = 0; n < 2; ++n) {
            const f32x4 x = acc[ai][0][m][n] * gv[n];
            *(GAS f32x4*)(rb + n * 16 + o0) = rot4(x, lat ? cc[m][n] : (f32x2){1.f, 1.f}, lat ? sn[m][n] : (f32x2){0.f, 0.f});
          }
        }
      }
    }
  }
};
struct EpiQKV {
  bf16_t *Q, *K, *V; const float *KR, *ssq_cq, *ssq_ckv, *ssq_kr; float* ssq_q; const float *g_mq, *g_mk, *cosM, *sinM; int pn_off;
  DI void operator()(const AccT& acc, const Unit& u, int wr, int wc, int fr, int fq) const {
    const bool lat = u.pm < 128; const int upn = u.pn + pn_off;
    const unsigned rowb = (unsigned)u.pm * 256u, rl0 = (unsigned)(wr * 64 + fr);
    const unsigned posb = rowb & 2047u;
    if (upn < 4) {
      const int head = upn * 2 + (wc >> 1), half = wc & 1;
      const char* sq_b = (const char*)(ssq_cq + (size_t)rowb * 4); char* ssq_o = (char*)(ssq_q + ((size_t)rowb * 8 + head) * 2 + half);
      const char* base = (const char*)(Q + (size_t)rowb * 768 + head * 96 + half * 64);
      const unsigned o0 = (rl0 * 768u + fq * 8) * 2u, ro0 = (rl0 * 16u + fq * 4) * 4u;
      const char* cb = (const char*)(cosM + posb * 16), *sbp = (const char*)(sinM + posb * 16);
      const bool rp = half == 1 && lat;
      f32x4 gv[2][2];
      COLS_LOOP gv[bj][n] = (half == 0 || bj == 0) ? ld4p((const char*)(g_mq + half * 64) + (bj * 32 + n * 4) * 4, fq * 32u) : (f32x4){0.f, 0.f, 0.f, 0.f};
#pragma unroll
      for (int aim = 0; aim < 4; ++aim) { const int ai = aim >> 1, m0 = (aim & 1) * 2;
        f32x4 s4[4]; f32x2 cc[4][2], sn[4][2];
#pragma unroll
        for (int m = m0; m < m0 + 2; ++m) { s4[m] = ld4p(sq_b + (ai * 128 + m * 16) * 16, rl0 * 16u);
#pragma unroll
          for (int n = 0; n < 2; ++n) { cc[m][n] = ld2p(cb + ((ai * 128 + m * 16) * 16 + n * 2) * 4, ro0); sn[m][n] = ld2p(sbp + ((ai * 128 + m * 16) * 16 + n * 2) * 4, ro0); } }
#pragma unroll
        for (int m = m0; m < m0 + 2; ++m) {
          const float rs = rsqrtf((s4[m][0] + s4[m][1] + s4[m][2] + s4[m][3]) * (1.f / 256.f) + EPS);
          const float ss = lane_ssq(acc, ai, m, rs);
          if (fq == 0) *(GAS float*)(ssq_o + (size_t)(ai * 128 + m * 16) * 64 + rl0 * 64u) = ss;
          char* rb = (char*)base + (size_t)(ai * 128 + m * 16) * 768 * 2;
#pragma unroll
          for (int bj = 0; bj < 2; ++bj) {
            if (half == 0 || bj == 0) { f32x4 y[2];
#pragma unroll
              for (int n = 0; n < 2; ++n) { const f32x4 x = acc[ai][bj][m][n] * rs * gv[bj][n];
                y[n] = half == 1 ? rot4(x, rp ? cc[m][n] : (f32x2){1.f, 1.f}, rp ? sn[m][n] : (f32x2){0.f, 0.f}) : x; }
              st8p(rb + bj * 64, o0, y[0], y[1]); }
          }
        }
      }
    } else {
      const int head = (upn - 4) * 2 + (wc >> 1), kind = wc & 1;
      const char* sc_b = (const char*)(ssq_ckv + (size_t)rowb * 2);
      if (kind == 0) {
        const char* skr_b = (const char*)(ssq_kr + rowb); const char* kr_b = (const char*)(KR + (size_t)rowb * 32);
        const char* base = (const char*)(K + (size_t)rowb * 768 + head * 96);
        const unsigned o0 = (rl0 * 768u + fq * 8) * 2u, o1 = (rl0 * 768u + 64 + fq * 8) * 2u, ko0 = (rl0 * 32u + fq * 8) * 4u;
        f32x4 gv[2][2];
        COLS_LOOP gv[bj][n] = ld4p((const char*)g_mk + (bj * 32 + n * 4) * 4, fq * 32u);
#pragma unroll
        for (int aim = 0; aim < 4; ++aim) { const int ai = aim >> 1, m0 = (aim & 1) * 2;
          f32x2 s2[4]; float skr[4]; f32x4 k0[4], k1[4];
#pragma unroll
          for (int m = m0; m < m0 + 2; ++m) { s2[m] = ld2p(sc_b + (ai * 128 + m * 16) * 8, rl0 * 8u); skr[m] = ld1p(skr_b + (ai * 128 + m * 16) * 4, rl0 * 4u);
            const char* krp = kr_b + (size_t)(ai * 128 + m * 16) * 32 * 4; k0[m] = ld4p(krp, ko0); k1[m] = ld4p(krp + 16, ko0); }
#pragma unroll
          for (int m = m0; m < m0 + 2; ++m) {
            const float rs = rsqrtf((s2[m][0] + s2[m][1]) * (1.f / 128.f) + EPS);
            const float ss = lane_ssq(acc, ai, m, rs);
            const float rk = rsqrtf((ss + skr[m]) * (1.f / 96.f) + EPS);
            char* rb = (char*)base + (size_t)(ai * 128 + m * 16) * 768 * 2;
#pragma unroll
            for (int bj = 0; bj < 2; ++bj) st8p(rb + bj * 64, o0, acc[ai][bj][m][0] * (rs * rk) * gv[bj][0], acc[ai][bj][m][1] * (rs * rk) * gv[bj][1]);
            st8p(rb, o1, k0[m] * rk, k1[m] * rk);
          }
        }
      } else {
        const char* base = (const char*)(V + (size_t)rowb * 512 + head * 64);
        const unsigned o0 = (rl0 * 512u + fq * 8) * 2u;
        f32x2 s2[2][4];
        ROWS_LOOP s2[ai][m] = ld2p(sc_b + (ai * 128 + m * 16) * 8, rl0 * 8u);
        ROWS_LOOP {
          const float rs = rsqrtf((s2[ai][m][0] + s2[ai][m][1]) * (1.f / 128.f) + EPS);
          char* rb = (char*)base + (size_t)(ai * 128 + m * 16) * 512 * 2;
#pragma unroll
          for (int bj = 0; bj < 2; ++bj) st8p(rb + bj * 64, o0, acc[ai][bj][m][0] * rs, acc[ai][bj][m][1] * rs);
        }
      }
    }
  }
};

#define MFMA32(a, b, c) __builtin_amdgcn_mfma_f32_32x32x16_bf16((a), (b), (c), 0, 0, 0)
template <int DK>
DI void attn_item(LAS unsigned char* lds, const int tid_in, const bf16_t* Qp, int ldq, const bf16_t* Kp, int ldk, const bf16_t* Vp, int ldv, bf16_t* Op, int ldo,
                  int q0, int s0row, int nt0, int s1row, int nt1, bool band, int qpos0, int kpos1,
                  const float* ssq, int ssq_stride, float cscale, float m_init, float l_init) {
  constexpr int KS = DK + 8, VS = 128 + 4, KBYTES = 128 * KS * 2, VBYTES = 64 * VS * 2, BUF = KBYTES + VBYTES;
  constexpr int CPK = DK / 8, NC = 128 * CPK / 512, NKC = DK / 16;
  int tid = tid_in; asm volatile("" : "+v"(tid));
  const int w = tid >> 6, lane = tid & 63, r = lane & 31, hh = lane >> 5;
  if (w >= 4) __builtin_amdgcn_s_setprio(1);
  const int qrow = q0 + w * 32 + r;
  float mrun = m_init, lrun = hh == 0 ? l_init : 0.f;
  f32x16 o0, o1;
#pragma unroll
  for (int i = 0; i < 16; ++i) { o0[i] = 0.f; o1[i] = 0.f; }
  const int nt = nt0 + nt1;
  u32x4 kreg[NC]; u32x2 vreg[4];
  const int vkg = tid >> 4, vdg = tid & 15;
  unsigned kgo[NC];
#pragma unroll
  for (int i_ = 0; i_ < NC; ++i_) { const int c_ = tid + i_ * 512, key_ = c_ / CPK, part_ = c_ % CPK; kgo[i_] = (unsigned)(key_ * ldk + part_ * 8) * 2u; }
  const unsigned vgo = (unsigned)(vkg * 4 * ldv + vdg * 4) * 2u;
#define AT_GLOAD(tt) do { const int krow_ = (tt) < nt0 ? s0row + (tt) * 128 : s1row + ((tt) - nt0) * 128; \
    const char* kbase_ = (const char*)Kp + (size_t)krow_ * ldk * 2; const char* vbase_ = (const char*)Vp + (size_t)krow_ * ldv * 2; \
    _Pragma("unroll") for (int i_ = 0; i_ < NC; ++i_) kreg[i_] = *(const GAS u32x4*)(kbase_ + kgo[i_]); \
    _Pragma("unroll") for (int j_ = 0; j_ < 4; ++j_) vreg[j_] = *(const GAS u32x2*)(vbase_ + (size_t)j_ * ldv * 2 + vgo); } while (0)
#define AT_LSTORE(bb) do { LAS unsigned char* kb_ = lds + (bb) * BUF; LAS unsigned char* vb_ = kb_ + KBYTES; \
    _Pragma("unroll") for (int i_ = 0; i_ < NC; ++i_) { const int c_ = tid + i_ * 512, key_ = c_ / CPK, part_ = c_ % CPK; *(LAS u32x4*)(kb_ + (key_ * KS + part_ * 8) * 2) = kreg[i_]; } \
    { u32x2 t0_ = {(vreg[0][0] & 0xffffu) | (vreg[1][0] << 16), (vreg[2][0] & 0xffffu) | (vreg[3][0] << 16)}; \
      u32x2 t1_ = {(vreg[0][0] >> 16) | (vreg[1][0] & 0xffff0000u), (vreg[2][0] >> 16) | (vreg[3][0] & 0xffff0000u)}; \
      u32x2 t2_ = {(vreg[0][1] & 0xffffu) | (vreg[1][1] << 16), (vreg[2][1] & 0xffffu) | (vreg[3][1] << 16)}; \
      u32x2 t3_ = {(vreg[0][1] >> 16) | (vreg[1][1] & 0xffff0000u), (vreg[2][1] >> 16) | (vreg[3][1] & 0xffff0000u)}; \
      *(LAS u32x2*)(vb_ + ((vdg * 4 + 0) * VS + vkg * 4) * 2) = t0_; *(LAS u32x2*)(vb_ + ((vdg * 4 + 1) * VS + vkg * 4) * 2) = t1_; \
      *(LAS u32x2*)(vb_ + ((vdg * 4 + 2) * VS + vkg * 4) * 2) = t2_; *(LAS u32x2*)(vb_ + ((vdg * 4 + 3) * VS + vkg * 4) * 2) = t3_; } } while (0)
  AT_GLOAD(0);
  bf16x8 qf[NKC];
#pragma unroll
  for (int kc = 0; kc < NKC; ++kc) qf[kc] = *(const GAS bf16x8*)(Qp + (size_t)qrow * ldq + kc * 16 + hh * 8);
  float cq = cscale;
  if (ssq) { const GAS float* sp = (const GAS float*)(ssq + (size_t)qrow * ssq_stride); cq *= rsqrtf((sp[0] + sp[1]) * (1.f / 96.f) + EPS); }
  AT_LSTORE(0); __syncthreads();
  for (int t = 0; t < nt; ++t) {
    const int buf = t & 1;
    if (t + 1 < nt) AT_GLOAD(t + 1);
    const bool masked = band && t >= nt0;
    const int kpos_t = kpos1 + (t - nt0) * 128, tq0 = qpos0 + w * 32;
    const bool active = !masked || !(kpos_t > tq0 + 31 + 128 || kpos_t + 127 < tq0 - 128);
    if (active) {
      const LAS unsigned char* kb = lds + buf * BUF; const LAS unsigned char* vb = kb + KBYTES;
      f32x16 s[4];
#define AT_LDK(dst, k4_) _Pragma("unroll") for (int kc = 0; kc < NKC; ++kc) dst[kc] = *(const LAS bf16x8*)(kb + (((k4_) * 32 + r) * KS + kc * 16 + hh * 8) * 2)
#define AT_MMK(src, k4_) do { _Pragma("unroll") for (int i = 0; i < 16; ++i) s[k4_][i] = 0.f; _Pragma("unroll") for (int kc = 0; kc < NKC; ++kc) s[k4_] = MFMA32(src[kc], qf[kc], s[k4_]); } while (0)
      { bf16x8 ka[NKC], kb2[NKC];
        AT_LDK(ka, 0); __builtin_amdgcn_sched_barrier(0);
        AT_LDK(kb2, 1); __builtin_amdgcn_sched_barrier(0); AT_MMK(ka, 0); __builtin_amdgcn_sched_barrier(0);
        AT_LDK(ka, 2); __builtin_amdgcn_sched_barrier(0); AT_MMK(kb2, 1); __builtin_amdgcn_sched_barrier(0);
        AT_LDK(kb2, 3); __builtin_amdgcn_sched_barrier(0); AT_MMK(ka, 2); __builtin_amdgcn_sched_barrier(0);
        AT_MMK(kb2, 3); __builtin_amdgcn_sched_barrier(0); }
#undef AT_LDK
#undef AT_MMK
      if (masked) {
#pragma unroll
        for (int k4 = 0; k4 < 4; ++k4)
#pragma unroll
          for (int i = 0; i < 16; ++i) { const int dd = (tq0 + r) - (kpos_t + k4 * 32 + (i & 3) + 8 * (i >> 2) + 4 * hh); if (dd > 128 || dd < -128) s[k4][i] = -1e30f; }
      }
      float mx = -3e38f;
#pragma unroll
      for (int k4 = 0; k4 < 4; ++k4)
#pragma unroll
        for (int i = 0; i < 16; i += 2) mx = fmaxf(fmaxf(mx, s[k4][i]), s[k4][i + 1]);
      mx = fmaxf(mx, __shfl_xor(mx, 32));
      const float mnew = fmaxf(mrun, mx * cq), alpha = fexp2(mrun - mnew); mrun = mnew;
      f32x2 ls2 = {0.f, 0.f}; const f32x2 cq2 = {cq, cq}, mn2 = {-mnew, -mnew};
#pragma unroll
      for (int k4 = 0; k4 < 4; ++k4)
#pragma unroll
        for (int i = 0; i < 16; i += 2) {
          f32x2 xv = {s[k4][i], s[k4][i + 1]}; xv = xv * cq2 + mn2;
          f32x2 pv = {fexp2(xv[0]), fexp2(xv[1])}; s[k4][i] = pv[0]; s[k4][i + 1] = pv[1]; ls2 += pv;
        }
      lrun = lrun * alpha + (ls2[0] + ls2[1]);
      if (__builtin_amdgcn_ballot_w64(alpha != 1.f) != 0ull) { o0 *= alpha; o1 *= alpha; }
#define AT_LDV(dst, k4_) _Pragma("unroll") for (int st = 0; st < 2; ++st) _Pragma("unroll") for (int blk = 0; blk < 2; ++blk) { \
          const LAS unsigned char* ad = vb + ((blk * 32 + r) * VS + (k4_) * 32 + 16 * st + 4 * hh) * 2; \
          const u32x2 lo = *(const LAS u32x2*)ad, hi = *(const LAS u32x2*)(ad + 16); u32x4 aw = {lo[0], lo[1], hi[0], hi[1]}; dst[st][blk] = __builtin_bit_cast(bf16x8, aw); }
#define AT_MMV(src, k4_) _Pragma("unroll") for (int st = 0; st < 2; ++st) { \
          u32x4 pw = {pk(s[k4_][8 * st + 0], s[k4_][8 * st + 1]), pk(s[k4_][8 * st + 2], s[k4_][8 * st + 3]), pk(s[k4_][8 * st + 4], s[k4_][8 * st + 5]), pk(s[k4_][8 * st + 6], s[k4_][8 * st + 7])}; \
          const bf16x8 pf = __builtin_bit_cast(bf16x8, pw); o0 = MFMA32(src[st][0], pf, o0); o1 = MFMA32(src[st][1], pf, o1); }
      { bf16x8 va[2][2], vb2[2][2];
        AT_LDV(va, 0); __builtin_amdgcn_sched_barrier(0);
        AT_LDV(vb2, 1); __builtin_amdgcn_sched_barrier(0); AT_MMV(va, 0); __builtin_amdgcn_sched_barrier(0);
        AT_LDV(va, 2); __builtin_amdgcn_sched_barrier(0); AT_MMV(vb2, 1); __builtin_amdgcn_sched_barrier(0);
        AT_LDV(vb2, 3); __builtin_amdgcn_sched_barrier(0); AT_MMV(va, 2); __builtin_amdgcn_sched_barrier(0);
        AT_MMV(vb2, 3); }
#undef AT_LDV
#undef AT_MMV
    }
    if (t + 1 < nt) AT_LSTORE(buf ^ 1);
    __syncthreads();
  }
#undef AT_GLOAD
#undef AT_LSTORE
  __builtin_amdgcn_s_setprio(0);
  const float lt = lrun + __shfl_xor(lrun, 32), inv = 1.f / lt;
  bf16_t* op = Op + (size_t)qrow * ldo + 4 * hh;
#pragma unroll
  for (int g4 = 0; g4 < 4; ++g4) {
    f32x4 a = {o0[4 * g4] * inv, o0[4 * g4 + 1] * inv, o0[4 * g4 + 2] * inv, o0[4 * g4 + 3] * inv};
    f32x4 b = {o1[4 * g4] * inv, o1[4 * g4 + 1] * inv, o1[4 * g4 + 2] * inv, o1[4 * g4 + 3] * inv};
    st4(op + 8 * g4, a); st4(op + 32 + 8 * g4, b);
  }
}

DI void lds_barrier() { asm volatile("s_waitcnt lgkmcnt(0)" ::: "memory"); __builtin_amdgcn_s_barrier(); asm volatile("" ::: "memory"); }
template <class F>
DI void prep_transpose(bf16_t* dst, int N, int K, F f, LAS float* tile, int& rot) {
  const int tid = threadIdx.x, ntk = K / 64, ntiles = (N / 64) * ntk;
  int tl = (int)((blockIdx.x + gridDim.x - (unsigned)rot % gridDim.x) % gridDim.x); rot += ntiles;
  float v[8];
  if (tl < ntiles) { const int n0 = (tl / ntk) * 64, k0 = (tl % ntk) * 64;
#pragma unroll
    for (int i = 0; i < 8; ++i) v[i] = f(n0 + (tid & 63), k0 + (tid >> 6) + i * 8); }
  while (tl < ntiles) {
    const int n0 = (tl / ntk) * 64, k0 = (tl % ntk) * 64;
#pragma unroll
    for (int i = 0; i < 8; ++i) tile[((tid >> 6) + i * 8) * 65 + (tid & 63)] = v[i];
    const int tn = tl + gridDim.x;
    if (tn < ntiles) { const int n1 = (tn / ntk) * 64, k1 = (tn % ntk) * 64;
#pragma unroll
      for (int i = 0; i < 8; ++i) v[i] = f(n1 + (tid & 63), k1 + (tid >> 6) + i * 8); }
    lds_barrier();
    { const int nn = tid >> 3, kc = tid & 7; float w[8];
#pragma unroll
      for (int j = 0; j < 8; ++j) w[j] = tile[(kc * 8 + j) * 65 + nn];
      u32x4 o = {pk(w[0], w[1]), pk(w[2], w[3]), pk(w[4], w[5]), pk(w[6], w[7])};
      *(u32x4*)(dst + (size_t)(n0 + nn) * K + k0 + kc * 8) = o; }
    lds_barrier();
    tl = tn;
  }
  __syncthreads();
}
DI int perm64(int n) { const int r = n & 31; return (n & ~255) + ((n >> 5) & 3) * 64 + ((n >> 7) & 1) * 32 + 8 * ((r & 15) >> 2) + 4 * (r >> 4) + (r & 3); }

DI void phase_prep(const Params& p, LAS unsigned char* lds) {
  const int tid = threadIdx.x, nb = gridDim.x, bid = blockIdx.x;
  const size_t gtid = (size_t)bid * 512 + tid, gstride = (size_t)nb * 512;
  unsigned char* ws = p.ws;
  { const f32x4* s = (const f32x4*)p.ctx; f32x4* d = (f32x4*)(ws + OFF_HCTX); const size_t n = (size_t)TC * D / 4; for (size_t i = gtid; i < n; i += gstride) d[i] = s[i]; }
  { LAS float* ctab = (LAS float*)lds; LAS float* stab = ctab + 2048;
    const float sc = 1.f / sqrtf(2048.f * 64.f), sc2 = 1.f / 128.f;
    for (int i = tid; i < 2048; i += 512) { float sv, cv; sincospif((float)i * (1.f / 1024.f), &sv, &cv); ctab[i] = cv; stab[i] = sv; }
    __syncthreads();
    bf16_t* dl = (bf16_t*)(ws + OFF_DFTL);
    for (size_t i = gtid; i < (size_t)2048 * 4096 / 8; i += gstride) { const int k = (int)(i / 512), kk0 = (int)(i % 512) * 8; float v[8];
#pragma unroll
      for (int j = 0; j < 8; ++j) { const int kk = kk0 + j, n = kk & 2047, ph = (k * n) & 2047; v[j] = (kk >> 11) ? -stab[ph] * sc : ctab[ph] * sc; }
      u32x4 o = {pk(v[0], v[1]), pk(v[2], v[3]), pk(v[4], v[5]), pk(v[6], v[7])}; *(u32x4*)(dl + i * 8) = o; }
    bf16_t* dc = (bf16_t*)(ws + OFF_DFTC);
    for (size_t i = gtid; i < (size_t)256 * 512 / 8; i += gstride) { const int k = (int)(i / 64), kk0 = (int)(i % 64) * 8; float v[8];
#pragma unroll
      for (int j = 0; j < 8; ++j) { const int kk = kk0 + j, n = kk & 255, ph = ((k * n) & 255) * 8; v[j] = (kk >> 8) ? -stab[ph] * sc2 : ctab[ph] * sc2; }
      u32x4 o = {pk(v[0], v[1]), pk(v[2], v[3]), pk(v[4], v[5]), pk(v[6], v[7])}; *(u32x4*)(dc + i * 8) = o; }
    __syncthreads(); }
  { float* cosS = (float*)(ws + OFF_ROPE); float* sinS = cosS + 2048 * 32; float* cosM = sinS + 2048 * 32; float* sinM = cosM + 2048 * 16;
    for (size_t i = gtid; i < (size_t)2048 * 32; i += gstride) { const int pos = (int)(i >> 5), pi = (int)(i & 31); const float pr = (float)(pos >> 6), pc = (float)(pos & 63);
      const float inv = powf(10000.f, -(float)(2 * (pi & 15)) / 32.f); const float ang = (pi < 16 ? pr : pc) * inv; cosS[i] = cosf(ang); sinS[i] = sinf(ang); }
    for (size_t i = gtid; i < (size_t)2048 * 16; i += gstride) { const int pos = (int)(i >> 4), pi = (int)(i & 15); const float pr = (float)(pos >> 6), pc = (float)(pos & 63);
      const float inv = powf(10000.f, -(float)(2 * (pi & 7)) / 16.f); const float ang = (pi < 8 ? pr : pc) * inv; cosM[i] = cosf(ang); sinM[i] = sinf(ang); } }
  LAS float* tile = (LAS float*)lds; int rot = 0;
#pragma unroll 1
  for (int l = 0; l < 4; ++l) {
    unsigned char* wl = ws + OFF_W + (size_t)l * W_LAYER;
#pragma unroll 1
    for (int f2 = 0; f2 < 2; ++f2) {
      const float* w1 = (f2 ? p.w1_ffn2 : p.w1_ffn1) + (size_t)l * D * DFF; const float* w3 = (f2 ? p.w3_ffn2 : p.w3_ffn1) + (size_t)l * D * DFF; const float* w2 = (f2 ? p.w2_ffn2 : p.w2_ffn1) + (size_t)l * DFF * D;
      prep_transpose((bf16_t*)(wl + (f2 ? WO_UP2 : WO_UP1)), 5632, 1024, [=](int n, int k) { const int t = n >> 8, s = n & 255, r = s & 31, hc = t * 128 + ((s >> 5) & 3) * 32 + 8 * ((r & 15) >> 2) + 4 * (r >> 4) + (r & 3);
          return ((s >> 7) ? w3 : w1)[(size_t)k * DFF + hc]; }, tile, rot);
      prep_transpose((bf16_t*)(wl + (f2 ? WO_DN2 : WO_DN1)), 1024, 2816, [=](int n, int k) { return w2[(size_t)k * D + n]; }, tile, rot);
    }
    { const float* wi = p.w_in + (size_t)l * D * 1184;
      prep_transpose((bf16_t*)(wl + WO_INB), 1024, 1024, [=](int n, int k) { const int L = perm64(n), tl = L >> 8, lc = L & 255; int col;
          if (tl == 0) col = 256 + lc; else if (tl == 1) col = 672 + lc; else if (tl == 2) col = lc < 128 ? 928 + lc : 1056 + (lc - 128); else col = lc < 128 ? 512 + lc : (lc < 160 ? 640 + (lc - 128) : -1);
          return col >= 0 ? wi[(size_t)k * 1184 + col] : 0.f; }, tile, rot); }
    { const float* wq = p.w_uq + (size_t)l * 256 * 768; const float* wkv = p.w_ukv + (size_t)l * 128 * 1024; const float* gq = p.g_cq + l * 256; const float* gkv = p.g_ckv + l * 128;
      prep_transpose((bf16_t*)(wl + WO_QKV), 1024, 256, [=](int n, int k) { const int L = perm64(n), tl = L >> 8, lc = L & 255;
          const int head = tl * 2 + (lc >> 7), dim = lc & 127; return dim < 96 ? gq[k] * wq[(size_t)k * 768 + head * 96 + dim] : 0.f; }, tile, rot);
      prep_transpose((bf16_t*)(wl + WO_QKV) + (size_t)1024 * 256, 1024, 128, [=](int n, int k) { const int L = perm64(n), tl = L >> 8, lc = L & 255;
          const int head = tl * 2 + (lc >> 7), wi2 = lc & 127; return gkv[k] * wkv[(size_t)k * 1024 + head * 128 + wi2]; }, tile, rot); }
    { const float* wo = p.w_out + (size_t)l * D * D;
      prep_transpose((bf16_t*)(wl + WO_OUT), 1024, 1024, [=](int n, int k) { return wo[(size_t)k * D + n]; }, tile, rot); }
    { const float* wi = p.w_in + (size_t)l * D * 1184; bf16_t* az = (bf16_t*)(wl + WO_AZ);
      LAS float* wt = (LAS float*)lds; LAS float* ct = wt + 64 * 65; LAS float* sn_t = ct + 64;
      for (int it = (bid + nb - (64 * l) % nb) % nb; it < 64; it += nb) {
        const int g = it >> 4, k0 = (it & 15) * 64;
        __syncthreads();
        if (tid < 64) { float sv, cv; sincospif((float)tid * (1.f / 32.f), &sv, &cv); ct[tid] = cv; sn_t[tid] = sv; }
#pragma unroll
        for (int i = 0; i < 8; ++i) { const int kk = (tid >> 6) + i * 8, cc = tid & 63; wt[kk * 65 + cc] = wi[(size_t)(k0 + kk) * 1184 + g * 64 + cc]; }
        __syncthreads();
        const int rr = tid >> 2, ks = (tid & 3) * 16, sn = rr >> 6, j = rr & 63; float v[16];
#pragma unroll
        for (int q = 0; q < 16; ++q) v[q] = 0.f;
        for (int cc = 0; cc < 64; ++cc) { const float tv = sn ? sn_t[(cc * j) & 63] : ct[(cc * j) & 63];
#pragma unroll
          for (int q = 0; q < 16; ++q) v[q] += wt[(ks + q) * 65 + cc] * tv; }
        u32x4 o0 = {pk(v[0], v[1]), pk(v[2], v[3]), pk(v[4], v[5]), pk(v[6], v[7])}, o1 = {pk(v[8], v[9]), pk(v[10], v[11]), pk(v[12], v[13]), pk(v[14], v[15])};
        bf16_t* dp = az + (size_t)(g * 128 + rr) * 1024 + k0 + ks; *(u32x4*)dp = o0; *(u32x4*)(dp + 8) = o1;
      }
      __syncthreads(); }
  }
  { LAS float* sc = (LAS float*)lds;
    LAS float* red = sc + 1024 * 20;
    __syncthreads();
    for (int i = tid; i < 17 * 1024; i += 512) { const int r = i >> 10, k = i & 1023; const float v = r < 16 ? p.c[r * 1024 + k] : p.c_ctx[k]; sc[k * 20 + r] = v / (1.f + __expf(-v)); }
    __syncthreads();
    float* MOD = (float*)(ws + OFF_MOD);
    for (int it = bid; it < 4 * 144; it += nb) {
      const int l = it / 144, col0 = (it % 144) * 64, ks = tid >> 6, col = tid & 63;
      const float* wp = p.w_ada + ((size_t)l * 1024 + ks * 128) * NMODW + col0 + col;
      float a[17];
#pragma unroll
      for (int r = 0; r < 17; ++r) a[r] = 0.f;
#pragma unroll 4
      for (int k = 0; k < 128; ++k) { const float wv = wp[(size_t)k * NMODW]; const LAS float* sp = sc + (ks * 128 + k) * 20;
        const f32x4 s0 = *(const LAS f32x4*)sp, s1 = *(const LAS f32x4*)(sp + 4), s2 = *(const LAS f32x4*)(sp + 8), s3 = *(const LAS f32x4*)(sp + 12); const float s16 = sp[16];
#pragma unroll
        for (int e = 0; e < 4; ++e) { a[e] += s0[e] * wv; a[4 + e] += s1[e] * wv; a[8 + e] += s2[e] * wv; a[12 + e] += s3[e] * wv; }
        a[16] += s16 * wv; }
#pragma unroll
      for (int r = 0; r < 17; ++r) red[(ks * 17 + r) * 64 + col] = a[r];
      __syncthreads();
      for (int i = tid; i < 17 * 64; i += 512) { const int r = i >> 6, cc = i & 63; float sum = p.b_ada[l * NMODW + col0 + cc];
#pragma unroll
        for (int q = 0; q < 8; ++q) sum += red[(q * 17 + r) * 64 + cc];
        MOD[((size_t)l * 17 + r) * NMODW + col0 + cc] = sum; }
      __syncthreads();
    } }
}

DI void phase_norm(const Params& p, const int tid, const float* hlat, const float* g, const float* modl, int sidx, int nrows, const float* pgate  , float pcoef) {
  const int w = tid >> 6, lane = tid & 63;
  float* hctx = (float*)(p.ws + OFF_HCTX); bf16_t* XN = (bf16_t*)(p.ws + OFF_XN); const float* pctx = (const float*)(p.ws + OFF_PCTX);
  f32x4 gv[4];
#pragma unroll
  for (int i = 0; i < 4; ++i) gv[i] = *(const GAS f32x4*)(g + (i * 64 + lane) * 4);
  for (int row0 = (blockIdx.x * 8 + w) * 4; row0 < nrows; row0 += gridDim.x * 32) {
    float* hp = row0 < TL ? const_cast<float*>(hlat) + (size_t)row0 * D : hctx + (size_t)(row0 - TL) * D; const int b = row0 < TL ? (row0 >> 11) : 16;
    const float* sh = modl + (size_t)b * NMODW + sidx * 1024; const float* scp = sh + 1024;
    const bool addp = pgate != nullptr && row0 >= TL;
    f32x4 xv[4][4]; float ss[4];
#pragma unroll
    for (int j = 0; j < 4; ++j)
#pragma unroll
      for (int i = 0; i < 4; ++i) xv[j][i] = *(const GAS f32x4*)(hp + (size_t)j * D + (i * 64 + lane) * 4);
    if (addp) {
      f32x4 pg[4], pc[4][4];
#pragma unroll
      for (int i = 0; i < 4; ++i) pg[i] = *(const GAS f32x4*)(pgate + (i * 64 + lane) * 4) * pcoef;
#pragma unroll
      for (int j = 0; j < 4; ++j)
#pragma unroll
        for (int i = 0; i < 4; ++i) pc[j][i] = *(const GAS f32x4*)(pctx + (size_t)(row0 + j - TL) * D + (i * 64 + lane) * 4);
#pragma unroll
      for (int j = 0; j < 4; ++j)
#pragma unroll
        for (int i = 0; i < 4; ++i) { xv[j][i] = xv[j][i] + pg[i] * pc[j][i]; *(GAS f32x4*)(hp + (size_t)j * D + (i * 64 + lane) * 4) = xv[j][i]; }
    }
#pragma unroll
    for (int j = 0; j < 4; ++j) { float t = 0.f;
#pragma unroll
      for (int i = 0; i < 4; ++i) t += xv[j][i][0] * xv[j][i][0] + xv[j][i][1] * xv[j][i][1] + xv[j][i][2] * xv[j][i][2] + xv[j][i][3] * xv[j][i][3];
      ss[j] = t; }
#pragma unroll
    for (int o = 1; o < 64; o <<= 1) {
#pragma unroll
      for (int j = 0; j < 4; ++j) ss[j] += __shfl_xor(ss[j], o); }
    f32x4 gsv[4], s0v[4];
#pragma unroll
    for (int i = 0; i < 4; ++i) { const int col = (i * 64 + lane) * 4; gsv[i] = gv[i] * (*(const GAS f32x4*)(scp + col) + 1.f); s0v[i] = *(const GAS f32x4*)(sh + col); }
#pragma unroll
    for (int i = 0; i < 4; ++i) { const int col = (i * 64 + lane) * 4;
#pragma unroll
      for (int j = 0; j < 4; ++j) st4(XN + (size_t)(row0 + j) * D + col, xv[j][i] * rsqrtf(ss[j] * (1.f / 1024.f) + EPS) * gsv[i] + s0v[i]); }
  }
}

DI void phase_attn(const Params& p, const int tid, LAS unsigned char* lds, int l, bool last) {
  unsigned char* ws = p.ws;
  const bf16_t* Qb = (const bf16_t*)(ws + OFF_Q); const bf16_t* Kb = (const bf16_t*)(ws + OFF_K); const bf16_t* Vb = (const bf16_t*)(ws + OFF_V);
  const bf16_t* SQ = (const bf16_t*)(ws + OFF_SQ); const bf16_t* SK = (const bf16_t*)(ws + OFF_SK); const bf16_t* SV = (const bf16_t*)(ws + OFF_SV);
  const float* ssq_q = (const float*)(ws + OFF_SSQ_Q); bf16_t* MIX = (bf16_t*)(ws + OFF_XN);
  const float LOG2E = 1.4426950408889634f;
  const int nitems = last ? 1536 : 1728;
  for (int it0 = blockIdx.x; it0 < nitems; it0 += gridDim.x) {
    int it = it0;
    if (gridDim.x == 256 && it0 < 1536) {
      const int c = blockIdx.x, xcd = c & 7, slot = c >> 3, rnd = it0 >> 8;
      it = (rnd < 4 ? 0 : 1024) + (((rnd & 3) * 32 + xcd * 4 + (slot >> 3)) << 3) + (slot & 7);
    }
    if (it < 1024 || (it >= 1536 && it < 1664)) {
      int b, h, q0, nt1;
      if (it < 1024) { b = it >> 6; h = (it >> 3) & 7; q0 = b * 2048 + (it & 7) * 256; nt1 = 16; }
      else { const int j = it - 1536; b = j >> 3; h = j & 7; q0 = TL + b * 256; nt1 = 0; }
      attn_item<96>(lds, tid, Qb + h * 96, 768, Kb + h * 96, 768, Vb + h * 64, 512, MIX + 256 + h * 64, 1024, q0, TL + b * 256, 2, b * 2048, nt1, false, 0, 0,
                    ssq_q + h * 2, 16, 0.10206207261596577f * LOG2E, -1e30f, 0.f);
    } else {
      int b, hq, q0, nt1, s1row, qpos0, kpos1;
      if (it < 1536) { const int j = it - 1024; b = j >> 5; hq = (j >> 3) & 3; const int qb = j & 7; qpos0 = qb * 256; q0 = b * 2048 + qpos0;
        const int st = qpos0 - 128 < 0 ? 0 : qpos0 - 128, en = qpos0 + 384 > 2048 ? 2048 : qpos0 + 384; kpos1 = st; s1row = b * 2048 + st; nt1 = (en - st) >> 7; }
      else { const int j = it - 1664; b = j >> 2; hq = j & 3; q0 = TL + b * 256; nt1 = 0; s1row = 0; qpos0 = 0; kpos1 = 0; }
      const int kvh = hq >> 1; const float sk = p.sink[l * 4 + hq] * LOG2E;
      attn_item<64>(lds, tid, SQ + hq * 64, 256, SK + kvh * 64, 128, SV + kvh * 64, 128, MIX + 768 + hq * 64, 1024, q0, TL + b * 256, 2, s1row, nt1, true, qpos0, kpos1,
                    nullptr, 0, LOG2E, sk, 1.f);
    }
  }
}

#define XB_TMO      128
#define XB_XCNT(j)  (256  + 64 * (j))
#define XB_XSUB(j)  (1280 + 64 * (j))
#define XB_XGEN(j)  (2304 + 64 * (j))
#define XB_TOP      3328
#define XB_TOPGEN   3392
#define XB_SPIN_CAP (1u << 22)
DI unsigned xb_ld(unsigned* p) { return __hip_atomic_load(p, __ATOMIC_RELAXED, __HIP_MEMORY_SCOPE_AGENT); }
DI unsigned xb_add(unsigned* p, unsigned v) { return __hip_atomic_fetch_add(p, v, __ATOMIC_RELAXED, __HIP_MEMORY_SCOPE_AGENT); }
DI unsigned xb_xcc_id() { return (unsigned)__builtin_amdgcn_s_getreg((3 << 11) | 20) & 0xFu; }
#define XB_SPIN(cond, bar) do { unsigned _sp = 0; while (cond) { __builtin_amdgcn_s_sleep(1); \
    if ((++_sp & 255u) == 0u) { if (xb_ld(&(bar)[XB_TMO])) break; if (_sp > XB_SPIN_CAP) { atomicAdd(&(bar)[XB_TMO], 1u); break; } } } } while (0)
DI void xcd_barrier_complete(unsigned* bar, unsigned x, unsigned& nloc, unsigned& nx) {
  const unsigned G = gridDim.x;
  unsigned sum, cnt, mine, sp = 0u;
  for (;;) {
    sum = 0u; cnt = 0u; mine = 0u;
#pragma unroll
    for (unsigned j = 0; j < 16; ++j) { const unsigned c = xb_ld(&bar[XB_XCNT(j)]); sum += c; cnt += (c > 0u) ? 1u : 0u; mine = (j == x) ? c : mine; }
    if (sum == G) break;
    __builtin_amdgcn_s_sleep(1);
    if ((++sp & 255u) == 0u) { if (xb_ld(&bar[XB_TMO])) break; if (sp > XB_SPIN_CAP) { atomicAdd(&bar[XB_TMO], 1u); break; } }
  }
  nloc = mine > 0u ? mine : 1u; nx = cnt > 0u ? cnt : 1u;
}
DI void xcd_barrier(unsigned* bar, volatile LAS unsigned* st) {
  asm volatile("s_waitcnt vmcnt(0)" ::: "memory");
  __syncthreads();
  if (threadIdx.x == 0) {
    const unsigned x = xb_xcc_id();
    __builtin_amdgcn_s_waitcnt(0);
    unsigned nloc = st[0], nx = st[1];
    if (nloc == 0u) { xcd_barrier_complete(bar, x, nloc, nx); st[0] = nloc; st[1] = nx; }
    const unsigned old = xb_add(&bar[XB_XSUB(x)], 1u);
    const unsigned gen = old / nloc;
    if (old + 1u == (gen + 1u) * nloc) {
      __builtin_amdgcn_fence(__ATOMIC_RELEASE, "agent");
      asm volatile("s_waitcnt vmcnt(0)" ::: "memory");
      const unsigned og = xb_add(&bar[XB_TOP], 1u);
      const unsigned tg = og / nx;
      if (og + 1u == (tg + 1u) * nx) xb_add(&bar[XB_TOPGEN], 1u);
      else XB_SPIN(xb_ld(&bar[XB_TOPGEN]) == tg, bar);
      __builtin_amdgcn_fence(__ATOMIC_ACQUIRE, "agent");
      xb_add(&bar[XB_XGEN(x)], 1u);
      asm volatile("s_waitcnt vmcnt(0)" ::: "memory");
    } else {
      XB_SPIN(xb_ld(&bar[XB_XGEN(x)]) == gen, bar);
      __builtin_amdgcn_fence(__ATOMIC_ACQUIRE, "agent");
      asm volatile("s_waitcnt vmcnt(0)" ::: "memory");
    }
  }
  __syncthreads();
}

#define PH_BEGIN() int tid = threadIdx.x; asm volatile("" : "+v"(tid)); unsigned char* ws_l_ = p.ws; asm volatile("" : "+s"(ws_l_)); unsigned char* ws = (unsigned char*)(GAS unsigned char*)ws_l_; Params q = p; q.ws = ws; \
  { float* o_ = p.out; asm volatile("" : "+s"(o_)); q.out = (float*)(GAS float*)o_; }
__global__ void __launch_bounds__(512, 2) mega(Params p) {
  extern __shared__ __attribute__((aligned(16))) unsigned char shm[];
  LAS unsigned char* lds = (LAS unsigned char*)shm;
  __builtin_assume(threadIdx.y == 0); __builtin_assume(threadIdx.z == 0);
  cg::grid_group grid = cg::this_grid();
  const int G = gridDim.x, bid = blockIdx.x;
  volatile LAS unsigned* xst = (volatile LAS unsigned*)(lds + 131072);
  { unsigned* bw = (unsigned*)(p.ws + OFF_BAR); for (int i = bid * 512 + (int)threadIdx.x; i < (int)(BAR_BYTES / 4); i += G * 512) bw[i] = 0u; }
  if (threadIdx.x == 0) { xst[0] = 0u; xst[1] = 0u; }
  __syncthreads();
  for (int rep = 0; rep < REP_PREP; ++rep) { phase_prep(p, lds); grid.sync(); }
  if (threadIdx.x == 0) (void)xb_add((unsigned*)(p.ws + OFF_BAR) + XB_XCNT(xb_xcc_id()), 1u);
#define GSYNC() do { unsigned char* wsb_ = p.ws; asm volatile("" : "+s"(wsb_)); xcd_barrier((unsigned*)(wsb_ + OFF_BAR), xst); } while (0)
#pragma unroll 1
  for (int step = 0; step < 12; ++step) {
    const int l = step / 3, kind = step % 3; const bool last = l == 3;
    const int nrows = (last && kind == 2) ? TL : T;
    { PH_BEGIN();
      const float* modl = (const float*)(ws + OFF_MOD) + (size_t)l * 17 * NMODW;
      const float* pgate = kind == 1 ? modl + (size_t)16 * NMODW + 2 * 1024 : kind == 2 ? modl + (size_t)16 * NMODW + 5 * 1024 : l > 0 ? modl - (size_t)NMODW + 8 * 1024 : nullptr;
      const float* hl0 = p.x; asm volatile("" : "+s"(hl0)); if (step != 0) hl0 = q.out;
      phase_norm(q, tid, hl0, (kind == 0 ? p.g_ffn1 : kind == 1 ? p.g_mix : p.g_ffn2) + l * D, modl, kind * 3, nrows, pgate, kind == 2 ? 1.f : 0.5f); }
    GSYNC();
    if (kind != 1) {
      { PH_BEGIN(); const unsigned char* wl = ws + OFF_W + (size_t)l * W_LAYER;
        EpiUp e{(bf16_t*)(ws + OFF_HID)}; run_gemm(lds, tid, (const bf16_t*)(ws + OFF_XN), (const bf16_t*)(wl + (kind == 0 ? WO_UP1 : WO_UP2)), nrows, 5632, 1024, e, G, bid); }
      GSYNC();
    } else {
      { PH_BEGIN(); const unsigned char* wl = ws + OFF_W + (size_t)l * W_LAYER;
        EpiZ e{(bf16_t*)(ws + OFF_ZTL), (bf16_t*)(ws + OFF_ZTC)}; run_gemm(lds, tid, (const bf16_t*)(wl + WO_AZ), (const bf16_t*)(ws + OFF_XN), 512, T, 1024, e, G, bid, 0, 0, 0, 1); }
      { PH_BEGIN(); const unsigned char* wl = ws + OFF_W + (size_t)l * W_LAYER;
        const float* cosS = (const float*)(ws + OFF_ROPE); const float* sinS = cosS + 2048 * 32; const float* cosM = sinS + 2048 * 32; const float* sinM = cosM + 2048 * 16;
        EpiInB e{(bf16_t*)(ws + OFF_LAT), (bf16_t*)(ws + OFF_SQ), (bf16_t*)(ws + OFF_SK), (bf16_t*)(ws + OFF_SV), (float*)(ws + OFF_KR), (float*)(ws + OFF_SSQ_CQ), (float*)(ws + OFF_SSQ_CKV),
                 (float*)(ws + OFF_SSQ_KR), p.g_swa_q + l * 64, p.g_swa_k + l * 64, p.g_mla_k + l * 96, cosS, sinS, cosM, sinM};
        run_gemm(lds, tid, (const bf16_t*)(ws + OFF_XN), (const bf16_t*)(wl + WO_INB), T, 1024, 1024, e, G, (bid + G - 32) % G); }
      GSYNC();
      { const int half = G >> 1;
        if (bid < half) { PH_BEGIN(); EpiFour e{(bf16_t*)(ws + OFF_XN), 0}; run_gemm(lds, tid, (const bf16_t*)(ws + OFF_DFTL), (const bf16_t*)(ws + OFF_ZTL), 2048, 4096, 4096, e, half, bid, 0, 0, 0, 1); }
        else {
#pragma unroll 1
          for (int pass = 0; pass < 2; ++pass) { PH_BEGIN(); const unsigned char* wl = ws + OFF_W + (size_t)l * W_LAYER;
            const float* cosM = (const float*)(ws + OFF_ROPE) + 2 * 2048 * 32; const float* sinM = cosM + 2048 * 16;
            EpiQKV e{(bf16_t*)(ws + OFF_Q), (bf16_t*)(ws + OFF_K), (bf16_t*)(ws + OFF_V), (const float*)(ws + OFF_KR), (const float*)(ws + OFF_SSQ_CQ), (const float*)(ws + OFF_SSQ_CKV),
                     (const float*)(ws + OFF_SSQ_KR), (float*)(ws + OFF_SSQ_Q), p.g_mla_q + l * 96, p.g_mla_k + l * 96, cosM, sinM, pass * 4};
            const int Gq = G - half, cq_ = bid - half, Kq = pass ? 128 : 256;
            run_gemm(lds, tid, (const bf16_t*)(ws + OFF_LAT) + pass * 256, (const bf16_t*)(wl + WO_QKV) + (size_t)pass * 1024 * 256, T, 1024, Kq, e, Gq, (cq_ + pass * (Gq >> 1)) % Gq, 0, 384, Kq); }
          if (!last) { PH_BEGIN(); EpiFour e2{(bf16_t*)(ws + OFF_XN), 1}; run_gemm(lds, tid, (const bf16_t*)(ws + OFF_DFTC), (const bf16_t*)(ws + OFF_ZTC), 256, 4096, 512, e2, G - half, bid - half, 0, 0, 0, 1); }
        } }
      GSYNC();
      { PH_BEGIN(); phase_attn(q, tid, lds, l, last); }
      GSYNC();
    }
#pragma unroll 1
    for (int pass = 0; pass < 2; ++pass) {
      if (pass == 1 && (bid >= 128 || (last && kind >= 1))) break;
      PH_BEGIN(); const unsigned char* wl = ws + OFF_W + (size_t)l * W_LAYER; const float* modl = (const float*)(ws + OFF_MOD) + (size_t)l * 17 * NMODW;
      const int Kf = kind == 1 ? 1024 : 2816, hf = bid >> 6;
      const bf16_t* Ar = kind == 1 ? (const bf16_t*)(ws + OFF_XN) : (const bf16_t*)(ws + OFF_HID);
      const bf16_t* Wr = (const bf16_t*)(wl + (kind == 0 ? WO_DN1 : kind == 1 ? WO_OUT : WO_DN2));
      const size_t koff = pass ? (size_t)hf * (Kf >> 1) : 0;
      const float* hs0 = p.x; asm volatile("" : "+s"(hs0)); if (step != 0) hs0 = q.out;
      EpiRes e{q.out, (float*)(ws + OFF_HCTX), modl + (kind * 3 + 2) * 1024, kind == 1 ? 1.f : 0.5f, (pass && hf) ? (float*)(ws + OFF_PCTX) : nullptr, hs0};
      run_gemm(lds, tid, Ar + koff, Wr + koff, pass ? TC : TL, 1024, pass ? (Kf >> 1) : Kf, e, pass ? 64 : G, pass ? (bid & 63) : bid, pass ? 128 : 0, Kf, Kf);
    }
    GSYNC();
  }
}

extern "C" void kernel_launch(void* const* d_in, const int* in_sizes, int n_in, void* d_out, int out_size, void* d_ws, size_t ws_size, hipStream_t stream) {
  (void)in_sizes; (void)n_in; (void)out_size;
  Params p{};
  const float** pp = (const float**)&p;
  for (int i = 0; i < 26; ++i) pp[i] = (const float*)d_in[i];
  p.out = (float*)d_out; p.ws = (unsigned char*)d_ws;
  static int grid_blocks = 0;
  if (!grid_blocks) {
    hipFuncSetAttribute((const void*)mega, hipFuncAttributeMaxDynamicSharedMemorySize, LDS_BYTES);
    int dev = 0, cus = 0, per_cu = 0;
    hipGetDevice(&dev);
    hipDeviceGetAttribute(&cus, hipDeviceAttributeMultiprocessorCount, dev);
    hipOccupancyMaxActiveBlocksPerMultiprocessor(&per_cu, mega, 512, LDS_BYTES);
    if (per_cu < 1) per_cu = 1;
    grid_blocks = cus;
    if (grid_blocks & 1) grid_blocks -= 1;
  }
  if (ws_size < WS_TOTAL) fprintf(stderr, "workspace too small: %zu < %zu\n", ws_size, (size_t)WS_TOTAL);
  void* args[] = {&p};
  hipError_t e = hipLaunchCooperativeKernel((void*)mega, dim3(grid_blocks), dim3(512), args, LDS_BYTES, stream);
  if (e != hipSuccess) fprintf(stderr, "cooperative launch failed: %s (grid %d)\n", hipGetErrorString(e), grid_blocks);
}
```

```cpp
#include <hip/hip_runtime.h>
#include <hip/hip_cooperative_groups.h>
#include <cstdio>
namespace cg = cooperative_groups;

#define LAS __attribute__((address_space(3)))
#define GAS __attribute__((address_space(1)))
#define DI __device__ __forceinline__
typedef unsigned short bf16_t;
typedef short bf16x8 __attribute__((ext_vector_type(8)));
typedef float f32x4 __attribute__((ext_vector_type(4)));
typedef float f32x2 __attribute__((ext_vector_type(2)));
typedef float f32x16 __attribute__((ext_vector_type(16)));
typedef unsigned u32x2 __attribute__((ext_vector_type(2)));
typedef unsigned u32x4 __attribute__((ext_vector_type(4)));
typedef __bf16 bf16x2_t __attribute__((ext_vector_type(2)));

constexpr int D = 1024, NB = 16, SEQ = 2048, CTXN = 256, TL = NB * SEQ, TC = NB * CTXN, T = TL + TC, DFF = 2816, NMODW = 9216;
constexpr float EPS = 1e-6f;
constexpr int LDS_BYTES = 131072 + 16;
#ifndef REP_ATTN
#define REP_ATTN 1
#endif
#ifndef REP_UP
#define REP_UP 1
#endif
#ifndef REP_NORM
#define REP_NORM 1
#endif
#ifndef REP_PREP
#define REP_PREP 1
#endif
#ifndef REP_INP
#define REP_INP 1
#endif
#ifndef REP_QKV
#define REP_QKV 1
#endif
#ifndef REP_DOWN
#define REP_DOWN 1
#endif
#ifndef REP_OUT
#define REP_OUT 1
#endif
#ifndef EXTRA_SYNC
#define EXTRA_SYNC 0
#endif

struct Params {
  const float *x, *c, *ctx, *c_ctx, *w_ada, *b_ada, *g_ffn1, *w1_ffn1, *w3_ffn1, *w2_ffn1, *g_mix, *w_in, *g_cq, *w_uq, *g_ckv, *w_ukv,
      *g_mla_q, *g_mla_k, *g_swa_q, *g_swa_k, *sink, *w_out, *g_ffn2, *w1_ffn2, *w3_ffn2, *w2_ffn2;
  float* out;
  unsigned char* ws;
};

constexpr size_t OFF_HCTX = 0;
constexpr size_t OFF_XN = OFF_HCTX + (size_t)TC * D * 4;
constexpr size_t OFF_HID = OFF_XN + (size_t)T * D * 2;
constexpr size_t OFF_ZTL = OFF_HID;
constexpr size_t OFF_ZTC = OFF_ZTL + (size_t)4096 * 4096 * 2;
constexpr size_t OFF_LAT = OFF_ZTC + (size_t)4096 * 512 * 2;
constexpr size_t OFF_Q = OFF_LAT + (size_t)T * 384 * 2;
constexpr size_t OFF_K = OFF_Q + (size_t)T * 768 * 2;
constexpr size_t OFF_HID_END = OFF_HID + (size_t)T * DFF * 2;
static_assert(OFF_K + (size_t)T * 768 * 2 <= OFF_HID_END, "alias overflow");
constexpr size_t OFF_V = OFF_HID_END;
constexpr size_t OFF_SQ = OFF_V + (size_t)T * 512 * 2;
constexpr size_t OFF_SK = OFF_SQ + (size_t)T * 256 * 2;
constexpr size_t OFF_SV = OFF_SK + (size_t)T * 128 * 2;
constexpr size_t OFF_KR = OFF_SV + (size_t)T * 128 * 2;
constexpr size_t OFF_SSQ_CQ = OFF_KR + (size_t)T * 32 * 4;
constexpr size_t OFF_SSQ_CKV = OFF_SSQ_CQ + (size_t)T * 4 * 4;
constexpr size_t OFF_SSQ_KR = OFF_SSQ_CKV + (size_t)T * 2 * 4;
constexpr size_t OFF_SSQ_Q = OFF_SSQ_KR + (size_t)T * 4;
constexpr size_t OFF_MOD = OFF_SSQ_Q + (size_t)T * 16 * 4;
constexpr size_t OFF_ROPE = OFF_MOD + (size_t)4 * 17 * NMODW * 4;
constexpr size_t OFF_DFTL = OFF_ROPE + (size_t)2048 * 96 * 4;
constexpr size_t OFF_DFTC = OFF_DFTL + (size_t)2048 * 4096 * 2;
constexpr size_t OFF_W = OFF_DFTC + (size_t)256 * 512 * 2;
constexpr size_t WO_UP1 = 0;
constexpr size_t WO_DN1 = WO_UP1 + (size_t)5632 * 1024 * 2;
constexpr size_t WO_UP2 = WO_DN1 + (size_t)1024 * 2816 * 2;
constexpr size_t WO_DN2 = WO_UP2 + (size_t)5632 * 1024 * 2;
constexpr size_t WO_INB = WO_DN2 + (size_t)1024 * 2816 * 2;
constexpr size_t WO_AZ = WO_INB + (size_t)1024 * 1024 * 2;
constexpr size_t WO_QKV = WO_AZ + (size_t)512 * 1024 * 2;
constexpr size_t WO_OUT = WO_QKV + (size_t)2048 * 384 * 2;
constexpr size_t W_LAYER = WO_OUT + (size_t)1024 * 1024 * 2;
constexpr size_t OFF_PCTX = OFF_W + 4 * W_LAYER;
constexpr size_t OFF_BAR = OFF_PCTX + (size_t)TC * D * 4;
constexpr size_t BAR_BYTES = 3456 * 4;
constexpr size_t WS_TOTAL = OFF_BAR + BAR_BYTES;
static_assert(WS_TOTAL < (size_t)615 * 1000 * 1000, "workspace too large");

DI unsigned pk(float a, float b) { f32x2 v = {a, b}; return __builtin_bit_cast(unsigned, __builtin_convertvector(v, bf16x2_t)); }
DI void st4(bf16_t* p, f32x4 v) { u32x2 o = {pk(v[0], v[1]), pk(v[2], v[3])}; *(GAS u32x2*)p = o; }
DI float fexp2(float x) { return __builtin_amdgcn_exp2f(x); }

namespace pg8 {
constexpr int BM = 256, BK = 64, HALF = 128, HTB = HALF * BK * 2, NXCD = 8, WGM = 8;
DI int lds_byte(int r, int c) { const int st = (r >> 4) * 2 + (c >> 5), rr = r & 15, cc = c & 31, ob = rr * 64 + cc * 2; return st * 1024 + (ob ^ (((ob >> 9) & 1) << 5)); }
DI void stage_rc(int b, int& R, int& C) { const int st = b / 1024, sb = b % 1024, swz = sb ^ (((sb >> 9) & 1) << 5); R = (st >> 1) * 16 + swz / 64; C = (st & 1) * 32 + (swz % 64) / 2; }
struct Unit { int pm, pn; };
struct Gemm { const bf16_t* A; const bf16_t* Bt; int M, N, K, lda, ldb, permB; };
struct StaticOrder {
  int nM, nN, nwg, G, c, pm_off;
  DI void init(int M, int N, int G_, int c_, int pm_off_ = 0) { nM = M / BM; nN = N / BM; nwg = nM * nN; G = G_; c = c_; pm_off = pm_off_; }
  DI bool next(int i, Unit& u) const {
    const long L = (long)i * G + c; if (L >= nwg) return false;
    int wgid = (int)L; { const int q = nwg / NXCD, r = nwg % NXCD, xcd = wgid % NXCD, off = wgid / NXCD; wgid = (xcd < r ? xcd * (q + 1) : r * (q + 1) + (xcd - r) * q) + off; }
    const int nig = WGM * nN, gid = wgid / nig, fm = gid * WGM, gsz = (nM - fm) < WGM ? (nM - fm) : WGM;
    u.pm = pm_off + fm + ((wgid % nig) % gsz); u.pn = (wgid % nig) / gsz; return true;
  }
};
template <class Epi, class Sched>
DI void gemm_phase(LAS unsigned char* lds, const int tid, const Gemm g, const Sched& S, const Epi& E) {
  const int wid = __builtin_amdgcn_readfirstlane(tid >> 6), lane = tid & 63, wr = wid >> 2, wc = wid & 3, fr = lane & 15, fq = lane >> 4;
  const int K = g.K, nt = K / BK;
  unsigned voffA[2], voffB[2];
#pragma unroll
  for (int i = 0; i < 2; ++i) { int R, C; stage_rc(tid * 16 + i * 8192, R, C); voffA[i] = (unsigned)(R * g.lda + C) * 2u;
    const int r5 = R & 31, Rb = g.permB ? ((R & ~31) + 8 * ((r5 & 15) >> 2) + 4 * (r5 >> 4) + (r5 & 3)) : R; voffB[i] = (unsigned)(Rb * g.ldb + C) * 2u; }
  const size_t kstep = (size_t)(BK * 2);
  const size_t hstepA = (size_t)HALF * g.lda * 2, hstepB = (size_t)HALF * g.ldb * 2;
  const size_t tstepA = 2 * hstepA, tstepB = 2 * hstepB;
  const unsigned ldsw = (unsigned)wid * 1024u;
  const int aoff = lds_byte(wr * 64 + fr, fq * 8), boff = lds_byte(wc * 32 + fr, fq * 8);
#define PG8_SA(b, h) (((b) * 2 + (h)) * HTB)
#define PG8_SB(b, h) ((4 + (b) * 2 + (h)) * HTB)
#define PG8_STAGE(bufoff, gbase, voff) do { _Pragma("unroll") for (int _i = 0; _i < 2; ++_i) \
    __builtin_amdgcn_global_load_lds((const unsigned*)((const char*)(gbase) + (voff)[_i]), (LAS unsigned*)(lds + (bufoff) + ldsw + _i * 8192), 16, 0, 0); } while (0)
#define PG8_LDA(dst, b, h) do { _Pragma("unroll") for (int m = 0; m < 4; ++m) _Pragma("unroll") for (int k = 0; k < 2; ++k) dst[m][k] = *(const LAS bf16x8*)(lds + PG8_SA(b, h) + aoff + m * 2048 + k * 1024); } while (0)
#define PG8_LDB(dst, b, h) do { _Pragma("unroll") for (int n = 0; n < 2; ++n) _Pragma("unroll") for (int k = 0; k < 2; ++k) dst[n][k] = *(const LAS bf16x8*)(lds + PG8_SB(b, h) + boff + n * 2048 + k * 1024); } while (0)
#define PG8_MMA(ai, bj, At, Bt) do { __builtin_amdgcn_s_setprio(1); _Pragma("unroll") for (int m = 0; m < 4; ++m) _Pragma("unroll") for (int n = 0; n < 2; ++n) _Pragma("unroll") for (int k = 0; k < 2; ++k) \
    acc[ai][bj][m][n] = __builtin_amdgcn_mfma_f32_16x16x32_bf16(Bt[n][k], At[m][k], acc[ai][bj][m][n], 0, 0, 0); __builtin_amdgcn_s_setprio(0); } while (0)
#define PG8_WAIT_V(n) asm volatile("s_waitcnt vmcnt(" #n ")" ::: "memory")
#define PG8_WAIT_L(n) asm volatile("s_waitcnt lgkmcnt(" #n ")" ::: "memory")
#define PG8_BAR __builtin_amdgcn_s_barrier()
#define PG8_SCHED __builtin_amdgcn_sched_barrier(0)
  Unit cur, nxt; int ui = 0;
  if (!S.next(0, cur)) return;
  f32x4 acc[2][2][4][2];
#pragma unroll
  for (int a = 0; a < 2; ++a)
#pragma unroll
    for (int b = 0; b < 2; ++b)
#pragma unroll
      for (int m = 0; m < 4; ++m)
#pragma unroll
        for (int n = 0; n < 2; ++n) acc[a][b][m][n] = (f32x4){0.f, 0.f, 0.f, 0.f};
  bf16x8 At[4][2], B0[2][2], B1[2][2];
  const char* cA = (const char*)g.A + (size_t)cur.pm * tstepA; const char* cB = (const char*)g.Bt + (size_t)cur.pn * tstepB;
  PG8_STAGE(PG8_SB(0, 0), cB, voffB); PG8_STAGE(PG8_SA(0, 0), cA, voffA); PG8_STAGE(PG8_SB(0, 1), cB + hstepB, voffB); PG8_STAGE(PG8_SA(0, 1), cA + hstepA, voffA);
  if (wr == 1) PG8_BAR;
  PG8_WAIT_V(4); PG8_BAR;
  PG8_STAGE(PG8_SB(1, 0), cB + kstep, voffB); PG8_STAGE(PG8_SA(1, 0), cA + kstep, voffA); PG8_STAGE(PG8_SB(1, 1), cB + hstepB + kstep, voffB);
  PG8_WAIT_V(6); PG8_BAR;
  for (;;) {
    const bool has_next = S.next(ui + 1, nxt);
    const char* nA = has_next ? (const char*)g.A + (size_t)nxt.pm * tstepA : cA; const char* nB = has_next ? (const char*)g.Bt + (size_t)nxt.pn * tstepB : cB;
#pragma unroll 1
    for (int t = 0; t < nt; t += 2) {
      const bool last = (t == nt - 2);
      const char* a1 = cA + (size_t)(t + 1) * kstep;
      const char* a2 = last ? nA : cA + (size_t)(t + 2) * kstep; const char* b2 = last ? nB : cB + (size_t)(t + 2) * kstep;
      const char* a3 = a2 + kstep; const char* b3 = b2 + kstep;
      PG8_LDB(B0, 0, 0); PG8_SCHED; PG8_LDA(At, 0, 0); PG8_STAGE(PG8_SA(1, 1), a1 + hstepA, voffA);
      PG8_WAIT_L(8); PG8_BAR; PG8_WAIT_L(0); PG8_MMA(0, 0, At, B0); PG8_BAR; PG8_SCHED;
      PG8_LDB(B1, 0, 1); PG8_STAGE(PG8_SB(0, 0), b2, voffB);
      PG8_BAR; PG8_WAIT_L(0); PG8_MMA(0, 1, At, B1); PG8_BAR;
      PG8_LDA(At, 0, 1); PG8_STAGE(PG8_SA(0, 0), a2, voffA);
      PG8_BAR; PG8_WAIT_L(0); PG8_MMA(1, 0, At, B0); PG8_BAR; PG8_SCHED;
      PG8_STAGE(PG8_SB(0, 1), b2 + hstepB, voffB);
      PG8_WAIT_V(6); PG8_BAR; PG8_MMA(1, 1, At, B1); PG8_BAR;
      PG8_LDB(B0, 1, 0); PG8_SCHED; PG8_LDA(At, 1, 0); PG8_STAGE(PG8_SA(0, 1), a2 + hstepA, voffA);
      PG8_WAIT_L(8); PG8_BAR; PG8_WAIT_L(0); PG8_MMA(0, 0, At, B0); PG8_BAR; PG8_SCHED;
      PG8_LDB(B1, 1, 1); PG8_STAGE(PG8_SB(1, 0), b3, voffB);
      PG8_BAR; PG8_WAIT_L(0); PG8_MMA(0, 1, At, B1); PG8_BAR;
      PG8_LDA(At, 1, 1); PG8_STAGE(PG8_SA(1, 0), a3, voffA);
      PG8_BAR; PG8_WAIT_L(0); PG8_MMA(1, 0, At, B0); PG8_BAR; PG8_SCHED;
      PG8_STAGE(PG8_SB(1, 1), b3 + hstepB, voffB);
      PG8_WAIT_V(6); PG8_BAR; PG8_MMA(1, 1, At, B1); PG8_BAR;
    }
    { int z_e = 0; asm volatile("" : "+v"(z_e)); const int lane_e = __builtin_amdgcn_mbcnt_hi(~0u, __builtin_amdgcn_mbcnt_lo(~0u, (unsigned)z_e));
      E(acc, cur, wr, wc, lane_e & 15, lane_e >> 4); }
    if (!has_next) break;
#pragma unroll
    for (int a = 0; a < 2; ++a)
#pragma unroll
      for (int b = 0; b < 2; ++b)
#pragma unroll
        for (int m = 0; m < 4; ++m)
#pragma unroll
          for (int n = 0; n < 2; ++n) acc[a][b][m][n] = (f32x4){0.f, 0.f, 0.f, 0.f};
    cur = nxt; cA = nA; cB = nB; ++ui;
  }
  PG8_WAIT_V(0);
  if (wr == 0) PG8_BAR;
  PG8_BAR;
#undef PG8_SA
#undef PG8_SB
#undef PG8_STAGE
#undef PG8_LDA
#undef PG8_LDB
#undef PG8_MMA
#undef PG8_WAIT_V
#undef PG8_WAIT_L
#undef PG8_BAR
#undef PG8_SCHED
}
}
using pg8::Unit;
typedef f32x4 AccT[2][2][4][2];

template <class Epi>
DI void run_gemm(LAS unsigned char* lds, const int tid, const bf16_t* A, const bf16_t* Bt, int M, int N, int K, const Epi& E, int G, int c, int pm_off = 0, int lda = 0, int ldb = 0, int permB = 0) {
  pg8::Gemm g{A, Bt, M, N, K, lda ? lda : K, ldb ? ldb : K, permB}; pg8::StaticOrder S; S.init(M, N, G, c, pm_off);
  pg8::gemm_phase<Epi, pg8::StaticOrder>(lds, tid, g, S, E);
}

DI void st8p(void* ub, unsigned voff, f32x4 a, f32x4 b) { u32x4 o = {pk(a[0], a[1]), pk(a[2], a[3]), pk(b[0], b[1]), pk(b[2], b[3])}; *(GAS u32x4*)((char*)ub + voff) = o; }
DI void st4p(void* ub, unsigned voff, f32x4 v) { u32x2 o = {pk(v[0], v[1]), pk(v[2], v[3])}; *(GAS u32x2*)((char*)ub + voff) = o; }
DI f32x4 ld4p(const void* ub, unsigned voff) { return *(const GAS f32x4*)((const char*)ub + voff); }
DI f32x2 ld2p(const void* ub, unsigned voff) { return *(const GAS f32x2*)((const char*)ub + voff); }
DI float ld1p(const void* ub, unsigned voff) { return *(const GAS float*)((const char*)ub + voff); }
#define ROWS_LOOP _Pragma("unroll") for (int ai = 0; ai < 2; ++ai) _Pragma("unroll") for (int m = 0; m < 4; ++m)
#define COLS_LOOP _Pragma("unroll") for (int bj = 0; bj < 2; ++bj) _Pragma("unroll") for (int n = 0; n < 2; ++n)
struct EpiUp {
  bf16_t* HID;
  DI void operator()(const AccT& acc, const Unit& u, int wr, int wc, int fr, int fq) const {
    const char* base = (const char*)(HID + (size_t)u.pm * 256 * DFF + u.pn * 128);
    const unsigned o0 = (unsigned)((wr * 64 + fr) * DFF + wc * 32 + fq * 8) * 2u;
    ROWS_LOOP {
      char* rb = (char*)base + (size_t)(ai * 128 + m * 16) * DFF * 2;
      f32x4 h[2];
#pragma unroll
      for (int n = 0; n < 2; ++n) {
        const f32x4 gt = acc[ai][0][m][n], up = acc[ai][1][m][n];
#pragma unroll
        for (int e = 0; e < 4; ++e) h[n][e] = gt[e] * __builtin_amdgcn_rcpf(1.f + __expf(-gt[e])) * up[e];
      }
      u32x4 o = {pk(h[0][0], h[0][1]), pk(h[0][2], h[0][3]), pk(h[1][0], h[1][1]), pk(h[1][2], h[1][3])};
      *(GAS u32x4*)(rb + o0) = o;
    }
  }
};
struct EpiRes {
  float* out; float* hctx; const float* gate; float coef; float* pctx; const float* hsrc;
  DI void operator()(const AccT& acc, const Unit& u, int wr, int wc, int fr, int fq) const {
    const int b = u.pm < 128 ? (u.pm >> 3) : 16;
    const unsigned c0 = (unsigned)(wc * 32 + fq * 4) * 4u, o0 = (unsigned)((wr * 64 + fr) * D) * 4u + c0;
    if (pctx) {
      char* pb = (char*)(pctx + (size_t)(u.pm - 128) * 256 * D + u.pn * 256);
      ROWS_LOOP {
        char* rb = pb + (size_t)(ai * 128 + m * 16) * D * 4;
        COLS_LOOP *(GAS f32x4*)(rb + (bj * 128 + n * 16) * 4 + o0) = acc[ai][bj][m][n];
      }
      return;
    }
    char* hb = (char*)((u.pm < 128 ? out + (size_t)u.pm * 256 * D : hctx + (size_t)(u.pm - 128) * 256 * D) + u.pn * 256);
    const char* hs = (const char*)((u.pm < 128 ? hsrc + (size_t)u.pm * 256 * D : hctx + (size_t)(u.pm - 128) * 256 * D) + u.pn * 256);
    const char* gp = (const char*)(gate + (size_t)b * NMODW + u.pn * 256);
    f32x4 gv[2][2];
    COLS_LOOP gv[bj][n] = ld4p(gp + (bj * 128 + n * 16) * 4, c0);
    __builtin_amdgcn_sched_barrier(0);
    COLS_LOOP gv[bj][n] = gv[bj][n] * coef;
#pragma unroll
    for (int ai = 0; ai < 2; ++ai) {
      f32x4 hv[4][2][2];
#pragma unroll
      for (int m = 0; m < 4; ++m) { const char* rs_ = hs + (size_t)(ai * 128 + m * 16) * D * 4;
        COLS_LOOP hv[m][bj][n] = *(const GAS f32x4*)(rs_ + (bj * 128 + n * 16) * 4 + o0); }
#pragma unroll
      for (int m = 0; m < 4; ++m) { char* rb = hb + (size_t)(ai * 128 + m * 16) * D * 4;
        COLS_LOOP *(GAS f32x4*)(rb + (bj * 128 + n * 16) * 4 + o0) = hv[m][bj][n] + gv[bj][n] * acc[ai][bj][m][n]; }
    }
  }
};
struct EpiZ {
  bf16_t *ZTL, *ZTC;
  DI void operator()(const AccT& acc, const Unit& u, int wr, int wc, int fr, int fq) const {
    const bool lat = u.pn < 128;
    const int ld = lat ? 4096 : 512, snoff = lat ? 2048 : 256;
    const char* base = (const char*)((lat ? ZTL + ((size_t)(u.pn >> 3) * 256 * 4096 + (u.pn & 7) * 256) : ZTC + (size_t)(u.pn - 128) * 256 * 512) + (size_t)(u.pm * 128) * ld + wr * snoff);
    const unsigned o0 = (unsigned)(fr * ld + wc * 32 + fq * 8) * 2u;
    ROWS_LOOP {
      char* rb = (char*)base + (size_t)((ai * 64 + m * 16) * ld) * 2;
#pragma unroll
      for (int bj = 0; bj < 2; ++bj) st8p(rb + bj * 256, o0, acc[ai][bj][m][0], acc[ai][bj][m][1]);
    }
  }
};
struct EpiFour {
  bf16_t* MIX; int ctx;
  DI void operator()(const AccT& acc, const Unit& u, int wr, int wc, int fr, int fq) const {
    const char* base = (const char*)(MIX + (ctx ? (size_t)(TL + u.pn * 256) : (size_t)(u.pn * 2048 + u.pm * 256)) * D);
    const unsigned o0 = (unsigned)((wr * 64 + fr) * D + wc * 32 + fq * 8) * 2u;
    ROWS_LOOP {
      char* rb = (char*)base + (size_t)(ai * 128 + m * 16) * D * 2;
#pragma unroll
      for (int bj = 0; bj < 2; ++bj) st8p(rb + bj * 256, o0, acc[ai][bj][m][0], acc[ai][bj][m][1]);
    }
  }
};
DI f32x4 rope4(f32x4 x, const void* ct, const void* st, unsigned voff) {
  const f32x2 c = ld2p(ct, voff), s = ld2p(st, voff);
  f32x4 y; y[0] = x[0] * c[0] - x[1] * s[0]; y[1] = x[0] * s[0] + x[1] * c[0]; y[2] = x[2] * c[1] - x[3] * s[1]; y[3] = x[2] * s[1] + x[3] * c[1]; return y;
}
DI float lane_ssq(const AccT& acc, int ai, int m, float sc) {
  float ss = 0.f;
#pragma unroll
  for (int bj = 0; bj < 2; ++bj)
#pragma unroll
    for (int n = 0; n < 2; ++n)
#pragma unroll
      for (int e = 0; e < 4; ++e) { const float v = acc[ai][bj][m][n][e] * sc; ss += v * v; }
  ss += __shfl_xor(ss, 16); ss += __shfl_xor(ss, 32); return ss;
}
DI f32x4 rot4(f32x4 x, f32x2 c, f32x2 s) { f32x4 y; y[0] = x[0] * c[0] - x[1] * s[0]; y[1] = x[0] * s[0] + x[1] * c[0]; y[2] = x[2] * c[1] - x[3] * s[1]; y[3] = x[2] * s[1] + x[3] * c[1]; return y; }
struct EpiInB {
  bf16_t *LAT, *SQ, *SK, *SV; float *KR, *ssq_cq, *ssq_ckv, *ssq_kr;
  const float *g_sq, *g_sk, *g_mk, *cosS, *sinS, *cosM, *sinM;
  DI void operator()(const AccT& acc, const Unit& u, int wr, int wc, int fr, int fq) const {
    const bool lat = u.pm < 128; const int pn = u.pn;
    const unsigned rowb = (unsigned)u.pm * 256u, rl0 = (unsigned)(wr * 64 + fr);
    const unsigned posb = rowb & 2047u;
    if (pn == 0 || (pn == 3 && wc < 2)) {
      const char* base = (const char*)(LAT + (size_t)rowb * 384 + (pn == 0 ? wc * 64 : 256 + wc * 64));
      const char* sb = pn == 0 ? (const char*)(ssq_cq + (size_t)rowb * 4 + wc) : (const char*)(ssq_ckv + (size_t)rowb * 2 + wc);
      const unsigned o0 = (rl0 * 384u + fq * 8) * 2u, so0 = rl0 * (pn == 0 ? 16u : 8u), sst = pn == 0 ? 16u : 8u;
      ROWS_LOOP {
        const float ss = lane_ssq(acc, ai, m, 1.f);
        char* rb = (char*)base + (size_t)(ai * 128 + m * 16) * 384 * 2;
#pragma unroll
        for (int bj = 0; bj < 2; ++bj) st8p(rb + bj * 64, o0, acc[ai][bj][m][0], acc[ai][bj][m][1]);
        if (fq == 0) *(GAS float*)((char*)sb + (size_t)(ai * 128 + m * 16) * sst + so0) = ss;
      }
    } else if (pn == 1 || (pn == 2 && wc < 2)) {
      const float* g = pn == 1 ? g_sq : g_sk; const float sc = pn == 1 ? 0.125f : 1.f;
      const unsigned ldo = pn == 1 ? 256u : 128u;
      const char* base = (const char*)((pn == 1 ? SQ + (size_t)rowb * 256 : SK + (size_t)rowb * 128) + wc * 64);
      const unsigned o0 = (rl0 * ldo + fq * 8) * 2u;
      const unsigned ro0 = (rl0 * 32u + fq * 4) * 4u;
      const char* cb = (const char*)(cosS + posb * 32), *sbp = (const char*)(sinS + posb * 32);
      f32x4 gv[2][2];
      COLS_LOOP gv[bj][n] = ld4p((const char*)g + (bj * 32 + n * 4) * 4, fq * 32u);
#pragma unroll
      for (int aim = 0; aim < 4; ++aim) { const int ai = aim >> 1, m0 = (aim & 1) * 2;
        f32x2 cc[4][2][2], sn[4][2][2];
#pragma unroll
        for (int m = m0; m < m0 + 2; ++m)
          COLS_LOOP { cc[m][bj][n] = ld2p(cb + ((ai * 128 + m * 16) * 32 + bj * 16 + n * 2) * 4, ro0); sn[m][bj][n] = ld2p(sbp + ((ai * 128 + m * 16) * 32 + bj * 16 + n * 2) * 4, ro0); }
#pragma unroll
        for (int m = m0; m < m0 + 2; ++m) {
          const float ss = lane_ssq(acc, ai, m, 1.f);
          const float rstd = rsqrtf(ss * (1.f / 64.f) + EPS);
          char* rb = (char*)base + (size_t)(ai * 128 + m * 16) * ldo * 2;
#pragma unroll
          for (int bj = 0; bj < 2; ++bj) { f32x4 y[2];
#pragma unroll
            for (int n = 0; n < 2; ++n) { const f32x4 x = acc[ai][bj][m][n] * rstd * gv[bj][n];
              y[n] = rot4(x, lat ? cc[m][bj][n] : (f32x2){1.f, 1.f}, lat ? sn[m][bj][n] : (f32x2){0.f, 0.f}) * sc; }
            st8p(rb + bj * 64, o0, y[0], y[1]); }
        }
      }
    } else if (pn == 2) {
      const char* base = (const char*)(SV + (size_t)rowb * 128 + (wc - 2) * 64);
      const unsigned o0 = (rl0 * 128u + fq * 8) * 2u;
      ROWS_LOOP {
        char* rb = (char*)base + (size_t)(ai * 128 + m * 16) * 128 * 2;
#pragma unroll
        for (int bj = 0; bj < 2; ++bj) st8p(rb + bj * 64, o0, acc[ai][bj][m][0], acc[ai][bj][m][1]);
      }
    } else if (wc == 2) {
      const char* base = (const char*)(KR + (size_t)rowb * 32);
      const char* sb = (const char*)(ssq_kr + rowb);
      const unsigned o0 = (rl0 * 32u + fq * 8) * 4u, ro0 = (rl0 * 16u + fq * 4) * 4u;
      const char* cb = (const char*)(cosM + posb * 16), *sbp = (const char*)(sinM + posb * 16);
      f32x4 gv[2];
#pragma unroll
      for (int n = 0; n < 2; ++n) gv[n] = ld4p((const char*)(g_mk + 64) + n * 16, fq * 32u);
#pragma unroll
      for (int aim = 0; aim < 4; ++aim) { const int ai = aim >> 1, m0 = (aim & 1) * 2;
        f32x2 cc[4][2], sn[4][2];
#pragma unroll
        for (int m = m0; m < m0 + 2; ++m)
#pragma unroll
          for (int n = 0; n < 2; ++n) { cc[m][n] = ld2p(cb + ((ai * 128 + m * 16) * 16 + n * 2) * 4, ro0); sn[m][n] = ld2p(sbp + ((ai * 128 + m * 16) * 16 + n * 2) * 4, ro0); }
#pragma unroll
        for (int m = m0; m < m0 + 2; ++m) {
          const float ss = lane_ssq(acc, ai, m, 1.f);
          if (fq == 0) *(GAS float*)((char*)sb + (size_t)(ai * 128 + m * 16) * 4 + rl0 * 4u) = ss;
          char* rb = (char*)base + (size_t)(ai * 128 + m * 16) * 32 * 4;
#pragma unroll
          for (int n = 0; n < 2; ++n) {
            const f32x4 x = acc[ai][0][m][n] * gv[n];
            *(GAS f32x4*)(rb + n * 16 + o0) = rot4(x, lat ? cc[m][n] : (f32x2){1.f, 1.f}, lat ? sn[m][n] : (f32x2){0.f, 0.f});
          }
        }
      }
    }
  }
};
struct EpiQKV {
  bf16_t *Q, *K, *V; const float *KR, *ssq_cq, *ssq_ckv, *ssq_kr; float* ssq_q; const float *g_mq, *g_mk, *cosM, *sinM; int pn_off;
  DI void operator()(const AccT& acc, const Unit& u, int wr, int wc, int fr, int fq) const {
    const bool lat = u.pm < 128; const int upn = u.pn + pn_off;
    const unsigned rowb = (unsigned)u.pm * 256u, rl0 = (unsigned)(wr * 64 + fr);
    const unsigned posb = rowb & 2047u;
    if (upn < 4) {
      const int head = upn * 2 + (wc >> 1), half = wc & 1;
      const char* sq_b = (const char*)(ssq_cq + (size_t)rowb * 4); char* ssq_o = (char*)(ssq_q + ((size_t)rowb * 8 + head) * 2 + half);
      const char* base = (const char*)(Q + (size_t)rowb * 768 + head * 96 + half * 64);
      const unsigned o0 = (rl0 * 768u + fq * 8) * 2u, ro0 = (rl0 * 16u + fq * 4) * 4u;
      const char* cb = (const char*)(cosM + posb * 16), *sbp = (const char*)(sinM + posb * 16);
      const bool rp = half == 1 && lat;
      f32x4 gv[2][2];
      COLS_LOOP gv[bj][n] = (half == 0 || bj == 0) ? ld4p((const char*)(g_mq + half * 64) + (bj * 32 + n * 4) * 4, fq * 32u) : (f32x4){0.f, 0.f, 0.f, 0.f};
#pragma unroll
      for (int aim = 0; aim < 4; ++aim) { const int ai = aim >> 1, m0 = (aim & 1) * 2;
        f32x4 s4[4]; f32x2 cc[4][2], sn[4][2];
#pragma unroll
        for (int m = m0; m < m0 + 2; ++m) { s4[m] = ld4p(sq_b + (ai * 128 + m * 16) * 16, rl0 * 16u);
#pragma unroll
          for (int n = 0; n < 2; ++n) { cc[m][n] = ld2p(cb + ((ai * 128 + m * 16) * 16 + n * 2) * 4, ro0); sn[m][n] = ld2p(sbp + ((ai * 128 + m * 16) * 16 + n * 2) * 4, ro0); } }
#pragma unroll
        for (int m = m0; m < m0 + 2; ++m) {
          const float rs = rsqrtf((s4[m][0] + s4[m][1] + s4[m][2] + s4[m][3]) * (1.f / 256.f) + EPS);
          const float ss = lane_ssq(acc, ai, m, rs);
          if (fq == 0) *(GAS float*)(ssq_o + (size_t)(ai * 128 + m * 16) * 64 + rl0 * 64u) = ss;
          char* rb = (char*)base + (size_t)(ai * 128 + m * 16) * 768 * 2;
#pragma unroll
          for (int bj = 0; bj < 2; ++bj) {
            if (half == 0 || bj == 0) { f32x4 y[2];
#pragma unroll
              for (int n = 0; n < 2; ++n) { const f32x4 x = acc[ai][bj][m][n] * rs * gv[bj][n];
                y[n] = half == 1 ? rot4(x, rp ? cc[m][n] : (f32x2){1.f, 1.f}, rp ? sn[m][n] : (f32x2){0.f, 0.f}) : x; }
              st8p(rb + bj * 64, o0, y[0], y[1]); }
          }
        }
      }
    } else {
      const int head = (upn - 4) * 2 + (wc >> 1), kind = wc & 1;
      const char* sc_b = (const char*)(ssq_ckv + (size_t)rowb * 2);
      if (kind == 0) {
        const char* skr_b = (const char*)(ssq_kr + rowb); const char* kr_b = (const char*)(KR + (size_t)rowb * 32);
        const char* base = (const char*)(K + (size_t)rowb * 768 + head * 96);
        const unsigned o0 = (rl0 * 768u + fq * 8) * 2u, o1 = (rl0 * 768u + 64 + fq * 8) * 2u, ko0 = (rl0 * 32u + fq * 8) * 4u;
        f32x4 gv[2][2];
        COLS_LOOP gv[bj][n] = ld4p((const char*)g_mk + (bj * 32 + n * 4) * 4, fq * 32u);
#pragma unroll
        for (int aim = 0; aim < 4; ++aim) { const int ai = aim >> 1, m0 = (aim & 1) * 2;
          f32x2 s2[4]; float skr[4]; f32x4 k0[4], k1[4];
#pragma unroll
          for (int m = m0; m < m0 + 2; ++m) { s2[m] = ld2p(sc_b + (ai * 128 + m * 16) * 8, rl0 * 8u); skr[m] = ld1p(skr_b + (ai * 128 + m * 16) * 4, rl0 * 4u);
            const char* krp = kr_b + (size_t)(ai * 128 + m * 16) * 32 * 4; k0[m] = ld4p(krp, ko0); k1[m] = ld4p(krp + 16, ko0); }
#pragma unroll
          for (int m = m0; m < m0 + 2; ++m) {
            const float rs = rsqrtf((s2[m][0] + s2[m][1]) * (1.f / 128.f) + EPS);
            const float ss = lane_ssq(acc, ai, m, rs);
            const float rk = rsqrtf((ss + skr[m]) * (1.f / 96.f) + EPS);
            char* rb = (char*)base + (size_t)(ai * 128 + m * 16) * 768 * 2;
#pragma unroll
            for (int bj = 0; bj < 2; ++bj) st8p(rb + bj * 64, o0, acc[ai][bj][m][0] * (rs * rk) * gv[bj][0], acc[ai][bj][m][1] * (rs * rk) * gv[bj][1]);
            st8p(rb, o1, k0[m] * rk, k1[m] * rk);
          }
        }
      } else {
        const char* base = (const char*)(V + (size_t)rowb * 512 + head * 64);
        const unsigned o0 = (rl0 * 512u + fq * 8) * 2u;
        f32x2 s2[2][4];
        ROWS_LOOP s2[ai][m] = ld2p(sc_b + (ai * 128 + m * 16) * 8, rl0 * 8u);
        ROWS_LOOP {
          const float rs = rsqrtf((s2[ai][m][0] + s2[ai][m][1]) * (1.f / 128.f) + EPS);
          char* rb = (char*)base + (size_t)(ai * 128 + m * 16) * 512 * 2;
#pragma unroll
          for (int bj = 0; bj < 2; ++bj) st8p(rb + bj * 64, o0, acc[ai][bj][m][0] * rs, acc[ai][bj][m][1] * rs);
        }
      }
    }
  }
};

#define MFMA32(a, b, c) __builtin_amdgcn_mfma_f32_32x32x16_bf16((a), (b), (c), 0, 0, 0)
template <int DK>
DI void attn_item(LAS unsigned char* lds, const int tid_in, const bf16_t* Qp, int ldq, const bf16_t* Kp, int ldk, const bf16_t* Vp, int ldv, bf16_t* Op, int ldo,
                  int q0, int s0row, int nt0, int s1row, int nt1, bool band, int qpos0, int kpos1,
                  const float* ssq, int ssq_stride, float cscale, float m_init, float l_init) {
  constexpr int KS = DK + 8, VS = 128 + 4, KBYTES = 128 * KS * 2, VBYTES = 64 * VS * 2, BUF = KBYTES + VBYTES;
  constexpr int CPK = DK / 8, NC = 128 * CPK / 512, NKC = DK / 16;
  int tid = tid_in; asm volatile("" : "+v"(tid));
  const int w = tid >> 6, lane = tid & 63, r = lane & 31, hh = lane >> 5;
  if (w >= 4) __builtin_amdgcn_s_setprio(1);
  const int qrow = q0 + w * 32 + r;
  float mrun = m_init, lrun = hh == 0 ? l_init : 0.f;
  f32x16 o0, o1;
#pragma unroll
  for (int i = 0; i < 16; ++i) { o0[i] = 0.f; o1[i] = 0.f; }
  const int nt = nt0 + nt1;
  u32x4 kreg[NC]; u32x2 vreg[4];
  const int vkg = tid >> 4, vdg = tid & 15;
  unsigned kgo[NC];
#pragma unroll
  for (int i_ = 0; i_ < NC; ++i_) { const int c_ = tid + i_ * 512, key_ = c_ / CPK, part_ = c_ % CPK; kgo[i_] = (unsigned)(key_ * ldk + part_ * 8) * 2u; }
  const unsigned vgo = (unsigned)(vkg * 4 * ldv + vdg * 4) * 2u;
#define AT_GLOAD(tt) do { const int krow_ = (tt) < nt0 ? s0row + (tt) * 128 : s1row + ((tt) - nt0) * 128; \
    const char* kbase_ = (const char*)Kp + (size_t)krow_ * ldk * 2; const char* vbase_ = (const char*)Vp + (size_t)krow_ * ldv * 2; \
    _Pragma("unroll") for (int i_ = 0; i_ < NC; ++i_) kreg[i_] = *(const GAS u32x4*)(kbase_ + kgo[i_]); \
    _Pragma("unroll") for (int j_ = 0; j_ < 4; ++j_) vreg[j_] = *(const GAS u32x2*)(vbase_ + (size_t)j_ * ldv * 2 + vgo); } while (0)
#define AT_LSTORE(bb) do { LAS unsigned char* kb_ = lds + (bb) * BUF; LAS unsigned char* vb_ = kb_ + KBYTES; \
    _Pragma("unroll") for (int i_ = 0; i_ < NC; ++i_) { const int c_ = tid + i_ * 512, key_ = c_ / CPK, part_ = c_ % CPK; *(LAS u32x4*)(kb_ + (key_ * KS + part_ * 8) * 2) = kreg[i_]; } \
    { u32x2 t0_ = {(vreg[0][0] & 0xffffu) | (vreg[1][0] << 16), (vreg[2][0] & 0xffffu) | (vreg[3][0] << 16)}; \
      u32x2 t1_ = {(vreg[0][0] >> 16) | (vreg[1][0] & 0xffff0000u), (vreg[2][0] >> 16) | (vreg[3][0] & 0xffff0000u)}; \
      u32x2 t2_ = {(vreg[0][1] & 0xffffu) | (vreg[1][1] << 16), (vreg[2][1] & 0xffffu) | (vreg[3][1] << 16)}; \
      u32x2 t3_ = {(vreg[0][1] >> 16) | (vreg[1][1] & 0xffff0000u), (vreg[2][1] >> 16) | (vreg[3][1] & 0xffff0000u)}; \
      *(LAS u32x2*)(vb_ + ((vdg * 4 + 0) * VS + vkg * 4) * 2) = t0_; *(LAS u32x2*)(vb_ + ((vdg * 4 + 1) * VS + vkg * 4) * 2) = t1_; \
      *(LAS u32x2*)(vb_ + ((vdg * 4 + 2) * VS + vkg * 4) * 2) = t2_; *(LAS u32x2*)(vb_ + ((vdg * 4 + 3) * VS + vkg * 4) * 2) = t3_; } } while (0)
  AT_GLOAD(0);
  bf16x8 qf[NKC];
#pragma unroll
  for (int kc = 0; kc < NKC; ++kc) qf[kc] = *(const GAS bf16x8*)(Qp + (size_t)qrow * ldq + kc * 16 + hh * 8);
  float cq = cscale;
  if (ssq) { const GAS float* sp = (const GAS float*)(ssq + (size_t)qrow * ssq_stride); cq *= rsqrtf((sp[0] + sp[1]) * (1.f / 96.f) + EPS); }
  AT_LSTORE(0); __syncthreads();
  for (int t = 0; t < nt; ++t) {
    const int buf = t & 1;
    if (t + 1 < nt) AT_GLOAD(t + 1);
    const bool masked = band && t >= nt0;
    const int kpos_t = kpos1 + (t - nt0) * 128, tq0 = qpos0 + w * 32;
    const bool active = !masked || !(kpos_t > tq0 + 31 + 128 || kpos_t + 127 < tq0 - 128);
    if (active) {
      const LAS unsigned char* kb = lds + buf * BUF; const LAS unsigned char* vb = kb + KBYTES;
      f32x16 s[4];
#define AT_LDK(dst, k4_) _Pragma("unroll") for (int kc = 0; kc < NKC; ++kc) dst[kc] = *(const LAS bf16x8*)(kb + (((k4_) * 32 + r) * KS + kc * 16 + hh * 8) * 2)
#define AT_MMK(src, k4_) do { _Pragma("unroll") for (int i = 0; i < 16; ++i) s[k4_][i] = 0.f; _Pragma("unroll") for (int kc = 0; kc < NKC; ++kc) s[k4_] = MFMA32(src[kc], qf[kc], s[k4_]); } while (0)
      { bf16x8 ka[NKC], kb2[NKC];
        AT_LDK(ka, 0); __builtin_amdgcn_sched_barrier(0);
        AT_LDK(kb2, 1); __builtin_amdgcn_sched_barrier(0); AT_MMK(ka, 0); __builtin_amdgcn_sched_barrier(0);
        AT_LDK(ka, 2); __builtin_amdgcn_sched_barrier(0); AT_MMK(kb2, 1); __builtin_amdgcn_sched_barrier(0);
        AT_LDK(kb2, 3); __builtin_amdgcn_sched_barrier(0); AT_MMK(ka, 2); __builtin_amdgcn_sched_barrier(0);
        AT_MMK(kb2, 3); __builtin_amdgcn_sched_barrier(0); }
#undef AT_LDK
#undef AT_MMK
      if (masked) {
#pragma unroll
        for (int k4 = 0; k4 < 4; ++k4)
#pragma unroll
          for (int i = 0; i < 16; ++i) { const int dd = (tq0 + r) - (kpos_t + k4 * 32 + (i & 3) + 8 * (i >> 2) + 4 * hh); if (dd > 128 || dd < -128) s[k4][i] = -1e30f; }
      }
      float mx = -3e38f;
#pragma unroll
      for (int k4 = 0; k4 < 4; ++k4)
#pragma unroll
        for (int i = 0; i < 16; i += 2) mx = fmaxf(fmaxf(mx, s[k4][i]), s[k4][i + 1]);
      mx = fmaxf(mx, __shfl_xor(mx, 32));
      const float mnew = fmaxf(mrun, mx * cq), alpha = fexp2(mrun - mnew); mrun = mnew;
      f32x2 ls2 = {0.f, 0.f}; const f32x2 cq2 = {cq, cq}, mn2 = {-mnew, -mnew};
#pragma unroll
      for (int k4 = 0; k4 < 4; ++k4)
#pragma unroll
        for (int i = 0; i < 16; i += 2) {
          f32x2 xv = {s[k4][i], s[k4][i + 1]}; xv = xv * cq2 + mn2;
          f32x2 pv = {fexp2(xv[0]), fexp2(xv[1])}; s[k4][i] = pv[0]; s[k4][i + 1] = pv[1]; ls2 += pv;
        }
      lrun = lrun * alpha + (ls2[0] + ls2[1]);
      o0 *= alpha; o1 *= alpha;
#define AT_LDV(dst, k4_) _Pragma("unroll") for (int st = 0; st < 2; ++st) _Pragma("unroll") for (int blk = 0; blk < 2; ++blk) { \
          const LAS unsigned char* ad = vb + ((blk * 32 + r) * VS + (k4_) * 32 + 16 * st + 4 * hh) * 2; \
          const u32x2 lo = *(const LAS u32x2*)ad, hi = *(const LAS u32x2*)(ad + 16); u32x4 aw = {lo[0], lo[1], hi[0], hi[1]}; dst[st][blk] = __builtin_bit_cast(bf16x8, aw); }
#define AT_MMV(src, k4_) _Pragma("unroll") for (int st = 0; st < 2; ++st) { \
          u32x4 pw = {pk(s[k4_][8 * st + 0], s[k4_][8 * st + 1]), pk(s[k4_][8 * st + 2], s[k4_][8 * st + 3]), pk(s[k4_][8 * st + 4], s[k4_][8 * st + 5]), pk(s[k4_][8 * st + 6], s[k4_][8 * st + 7])}; \
          const bf16x8 pf = __builtin_bit_cast(bf16x8, pw); o0 = MFMA32(src[st][0], pf, o0); o1 = MFMA32(src[st][1], pf, o1); }
      { bf16x8 va[2][2], vb2[2][2];
        AT_LDV(va, 0); __builtin_amdgcn_sched_barrier(0);
        AT_LDV(vb2, 1); __builtin_amdgcn_sched_barrier(0); AT_MMV(va, 0); __builtin_amdgcn_sched_barrier(0);
        AT_LDV(va, 2); __builtin_amdgcn_sched_barrier(0); AT_MMV(vb2, 1); __builtin_amdgcn_sched_barrier(0);
        AT_LDV(vb2, 3); __builtin_amdgcn_sched_barrier(0); AT_MMV(va, 2); __builtin_amdgcn_sched_barrier(0);
        AT_MMV(vb2, 3); }
#undef AT_LDV
#undef AT_MMV
    }
    if (t + 1 < nt) AT_LSTORE(buf ^ 1);
    __syncthreads();
  }
#undef AT_GLOAD
#undef AT_LSTORE
  __builtin_amdgcn_s_setprio(0);
  const float lt = lrun + __shfl_xor(lrun, 32), inv = 1.f / lt;
  bf16_t* op = Op + (size_t)qrow * ldo + 4 * hh;
#pragma unroll
  for (int g4 = 0; g4 < 4; ++g4) {
    f32x4 a = {o0[4 * g4] * inv, o0[4 * g4 + 1] * inv, o0[4 * g4 + 2] * inv, o0[4 * g4 + 3] * inv};
    f32x4 b = {o1[4 * g4] * inv, o1[4 * g4 + 1] * inv, o1[4 * g4 + 2] * inv, o1[4 * g4 + 3] * inv};
    st4(op + 8 * g4, a); st4(op + 32 + 8 * g4, b);
  }
}

DI void lds_barrier() { asm volatile("s_waitcnt lgkmcnt(0)" ::: "memory"); __builtin_amdgcn_s_barrier(); asm volatile("" ::: "memory"); }
template <class F>
DI void prep_transpose(bf16_t* dst, int N, int K, F f, LAS float* tile, int& rot) {
  const int tid = threadIdx.x, ntk = K / 64, ntiles = (N / 64) * ntk;
  int tl = (int)((blockIdx.x + gridDim.x - (unsigned)rot % gridDim.x) % gridDim.x); rot += ntiles;
  float v[8];
  if (tl < ntiles) { const int n0 = (tl / ntk) * 64, k0 = (tl % ntk) * 64;
#pragma unroll
    for (int i = 0; i < 8; ++i) v[i] = f(n0 + (tid & 63), k0 + (tid >> 6) + i * 8); }
  while (tl < ntiles) {
    const int n0 = (tl / ntk) * 64, k0 = (tl % ntk) * 64;
#pragma unroll
    for (int i = 0; i < 8; ++i) tile[((tid >> 6) + i * 8) * 65 + (tid & 63)] = v[i];
    const int tn = tl + gridDim.x;
    if (tn < ntiles) { const int n1 = (tn / ntk) * 64, k1 = (tn % ntk) * 64;
#pragma unroll
      for (int i = 0; i < 8; ++i) v[i] = f(n1 + (tid & 63), k1 + (tid >> 6) + i * 8); }
    lds_barrier();
    { const int nn = tid >> 3, kc = tid & 7; float w[8];
#pragma unroll
      for (int j = 0; j < 8; ++j) w[j] = tile[(kc * 8 + j) * 65 + nn];
      u32x4 o = {pk(w[0], w[1]), pk(w[2], w[3]), pk(w[4], w[5]), pk(w[6], w[7])};
      *(u32x4*)(dst + (size_t)(n0 + nn) * K + k0 + kc * 8) = o; }
    lds_barrier();
    tl = tn;
  }
  __syncthreads();
}
DI int perm64(int n) { const int r = n & 31; return (n & ~255) + ((n >> 5) & 3) * 64 + ((n >> 7) & 1) * 32 + 8 * ((r & 15) >> 2) + 4 * (r >> 4) + (r & 3); }

DI void phase_prep(const Params& p, LAS unsigned char* lds) {
  const int tid = threadIdx.x, nb = gridDim.x, bid = blockIdx.x;
  const size_t gtid = (size_t)bid * 512 + tid, gstride = (size_t)nb * 512;
  unsigned char* ws = p.ws;
  { const f32x4* s = (const f32x4*)p.ctx; f32x4* d = (f32x4*)(ws + OFF_HCTX); const size_t n = (size_t)TC * D / 4; for (size_t i = gtid; i < n; i += gstride) d[i] = s[i]; }
  { LAS float* ctab = (LAS float*)lds; LAS float* stab = ctab + 2048;
    const float sc = 1.f / sqrtf(2048.f * 64.f), sc2 = 1.f / 128.f;
    for (int i = tid; i < 2048; i += 512) { float sv, cv; sincospif((float)i * (1.f / 1024.f), &sv, &cv); ctab[i] = cv; stab[i] = sv; }
    __syncthreads();
    bf16_t* dl = (bf16_t*)(ws + OFF_DFTL);
    for (size_t i = gtid; i < (size_t)2048 * 4096 / 8; i += gstride) { const int k = (int)(i / 512), kk0 = (int)(i % 512) * 8; float v[8];
#pragma unroll
      for (int j = 0; j < 8; ++j) { const int kk = kk0 + j, n = kk & 2047, ph = (k * n) & 2047; v[j] = (kk >> 11) ? -stab[ph] * sc : ctab[ph] * sc; }
      u32x4 o = {pk(v[0], v[1]), pk(v[2], v[3]), pk(v[4], v[5]), pk(v[6], v[7])}; *(u32x4*)(dl + i * 8) = o; }
    bf16_t* dc = (bf16_t*)(ws + OFF_DFTC);
    for (size_t i = gtid; i < (size_t)256 * 512 / 8; i += gstride) { const int k = (int)(i / 64), kk0 = (int)(i % 64) * 8; float v[8];
#pragma unroll
      for (int j = 0; j < 8; ++j) { const int kk = kk0 + j, n = kk & 255, ph = ((k * n) & 255) * 8; v[j] = (kk >> 8) ? -stab[ph] * sc2 : ctab[ph] * sc2; }
      u32x4 o = {pk(v[0], v[1]), pk(v[2], v[3]), pk(v[4], v[5]), pk(v[6], v[7])}; *(u32x4*)(dc + i * 8) = o; }
    __syncthreads(); }
  { float* cosS = (float*)(ws + OFF_ROPE); float* sinS = cosS + 2048 * 32; float* cosM = sinS + 2048 * 32; float* sinM = cosM + 2048 * 16;
    for (size_t i = gtid; i < (size_t)2048 * 32; i += gstride) { const int pos = (int)(i >> 5), pi = (int)(i & 31); const float pr = (float)(pos >> 6), pc = (float)(pos & 63);
      const float inv = powf(10000.f, -(float)(2 * (pi & 15)) / 32.f); const float ang = (pi < 16 ? pr : pc) * inv; cosS[i] = cosf(ang); sinS[i] = sinf(ang); }
    for (size_t i = gtid; i < (size_t)2048 * 16; i += gstride) { const int pos = (int)(i >> 4), pi = (int)(i & 15); const float pr = (float)(pos >> 6), pc = (float)(pos & 63);
      const float inv = powf(10000.f, -(float)(2 * (pi & 7)) / 16.f); const float ang = (pi < 8 ? pr : pc) * inv; cosM[i] = cosf(ang); sinM[i] = sinf(ang); } }
  LAS float* tile = (LAS float*)lds; int rot = 0;
#pragma unroll 1
  for (int l = 0; l < 4; ++l) {
    unsigned char* wl = ws + OFF_W + (size_t)l * W_LAYER;
#pragma unroll 1
    for (int f2 = 0; f2 < 2; ++f2) {
      const float* w1 = (f2 ? p.w1_ffn2 : p.w1_ffn1) + (size_t)l * D * DFF; const float* w3 = (f2 ? p.w3_ffn2 : p.w3_ffn1) + (size_t)l * D * DFF; const float* w2 = (f2 ? p.w2_ffn2 : p.w2_ffn1) + (size_t)l * DFF * D;
      prep_transpose((bf16_t*)(wl + (f2 ? WO_UP2 : WO_UP1)), 5632, 1024, [=](int n, int k) { const int t = n >> 8, s = n & 255, r = s & 31, hc = t * 128 + ((s >> 5) & 3) * 32 + 8 * ((r & 15) >> 2) + 4 * (r >> 4) + (r & 3);
          return ((s >> 7) ? w3 : w1)[(size_t)k * DFF + hc]; }, tile, rot);
      prep_transpose((bf16_t*)(wl + (f2 ? WO_DN2 : WO_DN1)), 1024, 2816, [=](int n, int k) { return w2[(size_t)k * D + n]; }, tile, rot);
    }
    { const float* wi = p.w_in + (size_t)l * D * 1184;
      prep_transpose((bf16_t*)(wl + WO_INB), 1024, 1024, [=](int n, int k) { const int L = perm64(n), tl = L >> 8, lc = L & 255; int col;
          if (tl == 0) col = 256 + lc; else if (tl == 1) col = 672 + lc; else if (tl == 2) col = lc < 128 ? 928 + lc : 1056 + (lc - 128); else col = lc < 128 ? 512 + lc : (lc < 160 ? 640 + (lc - 128) : -1);
          return col >= 0 ? wi[(size_t)k * 1184 + col] : 0.f; }, tile, rot); }
    { const float* wq = p.w_uq + (size_t)l * 256 * 768; const float* wkv = p.w_ukv + (size_t)l * 128 * 1024; const float* gq = p.g_cq + l * 256; const float* gkv = p.g_ckv + l * 128;
      prep_transpose((bf16_t*)(wl + WO_QKV), 1024, 256, [=](int n, int k) { const int L = perm64(n), tl = L >> 8, lc = L & 255;
          const int head = tl * 2 + (lc >> 7), dim = lc & 127; return dim < 96 ? gq[k] * wq[(size_t)k * 768 + head * 96 + dim] : 0.f; }, tile, rot);
      prep_transpose((bf16_t*)(wl + WO_QKV) + (size_t)1024 * 256, 1024, 128, [=](int n, int k) { const int L = perm64(n), tl = L >> 8, lc = L & 255;
          const int head = tl * 2 + (lc >> 7), wi2 = lc & 127; return gkv[k] * wkv[(size_t)k * 1024 + head * 128 + wi2]; }, tile, rot); }
    { const float* wo = p.w_out + (size_t)l * D * D;
      prep_transpose((bf16_t*)(wl + WO_OUT), 1024, 1024, [=](int n, int k) { return wo[(size_t)k * D + n]; }, tile, rot); }
    { const float* wi = p.w_in + (size_t)l * D * 1184; bf16_t* az = (bf16_t*)(wl + WO_AZ);
      LAS float* wt = (LAS float*)lds; LAS float* ct = wt + 64 * 65; LAS float* sn_t = ct + 64;
      for (int it = (bid + nb - (64 * l) % nb) % nb; it < 64; it += nb) {
        const int g = it >> 4, k0 = (it & 15) * 64;
        __syncthreads();
        if (tid < 64) { float sv, cv; sincospif((float)tid * (1.f / 32.f), &sv, &cv); ct[tid] = cv; sn_t[tid] = sv; }
#pragma unroll
        for (int i = 0; i < 8; ++i) { const int kk = (tid >> 6) + i * 8, cc = tid & 63; wt[kk * 65 + cc] = wi[(size_t)(k0 + kk) * 1184 + g * 64 + cc]; }
        __syncthreads();
        const int rr = tid >> 2, ks = (tid & 3) * 16, sn = rr >> 6, j = rr & 63; float v[16];
#pragma unroll
        for (int q = 0; q < 16; ++q) v[q] = 0.f;
        for (int cc = 0; cc < 64; ++cc) { const float tv = sn ? sn_t[(cc * j) & 63] : ct[(cc * j) & 63];
#pragma unroll
          for (int q = 0; q < 16; ++q) v[q] += wt[(ks + q) * 65 + cc] * tv; }
        u32x4 o0 = {pk(v[0], v[1]), pk(v[2], v[3]), pk(v[4], v[5]), pk(v[6], v[7])}, o1 = {pk(v[8], v[9]), pk(v[10], v[11]), pk(v[12], v[13]), pk(v[14], v[15])};
        bf16_t* dp = az + (size_t)(g * 128 + rr) * 1024 + k0 + ks; *(u32x4*)dp = o0; *(u32x4*)(dp + 8) = o1;
      }
      __syncthreads(); }
  }
  { LAS float* sc = (LAS float*)lds;
    LAS float* red = sc + 1024 * 20;
    __syncthreads();
    for (int i = tid; i < 17 * 1024; i += 512) { const int r = i >> 10, k = i & 1023; const float v = r < 16 ? p.c[r * 1024 + k] : p.c_ctx[k]; sc[k * 20 + r] = v / (1.f + __expf(-v)); }
    __syncthreads();
    float* MOD = (float*)(ws + OFF_MOD);
    for (int it = bid; it < 4 * 144; it += nb) {
      const int l = it / 144, col0 = (it % 144) * 64, ks = tid >> 6, col = tid & 63;
      const float* wp = p.w_ada + ((size_t)l * 1024 + ks * 128) * NMODW + col0 + col;
      float a[17];
#pragma unroll
      for (int r = 0; r < 17; ++r) a[r] = 0.f;
#pragma unroll 4
      for (int k = 0; k < 128; ++k) { const float wv = wp[(size_t)k * NMODW]; const LAS float* sp = sc + (ks * 128 + k) * 20;
        const f32x4 s0 = *(const LAS f32x4*)sp, s1 = *(const LAS f32x4*)(sp + 4), s2 = *(const LAS f32x4*)(sp + 8), s3 = *(const LAS f32x4*)(sp + 12); const float s16 = sp[16];
#pragma unroll
        for (int e = 0; e < 4; ++e) { a[e] += s0[e] * wv; a[4 + e] += s1[e] * wv; a[8 + e] += s2[e] * wv; a[12 + e] += s3[e] * wv; }
        a[16] += s16 * wv; }
#pragma unroll
      for (int r = 0; r < 17; ++r) red[(ks * 17 + r) * 64 + col] = a[r];
      __syncthreads();
      for (int i = tid; i < 17 * 64; i += 512) { const int r = i >> 6, cc = i & 63; float sum = p.b_ada[l * NMODW + col0 + cc];
#pragma unroll
        for (int q = 0; q < 8; ++q) sum += red[(q * 17 + r) * 64 + cc];
        MOD[((size_t)l * 17 + r) * NMODW + col0 + cc] = sum; }
      __syncthreads();
    } }
}

DI void phase_norm(const Params& p, const int tid, const float* hlat, const float* g, const float* modl, int sidx, int nrows, const float* pgate  , float pcoef) {
  const int w = tid >> 6, lane = tid & 63;
  float* hctx = (float*)(p.ws + OFF_HCTX); bf16_t* XN = (bf16_t*)(p.ws + OFF_XN); const float* pctx = (const float*)(p.ws + OFF_PCTX);
  f32x4 gv[4];
#pragma unroll
  for (int i = 0; i < 4; ++i) gv[i] = *(const GAS f32x4*)(g + (i * 64 + lane) * 4);
  for (int row0 = (w * gridDim.x + blockIdx.x) * 4; row0 < nrows; row0 += gridDim.x * 32) {
    float* hp = row0 < TL ? const_cast<float*>(hlat) + (size_t)row0 * D : hctx + (size_t)(row0 - TL) * D; const int b = row0 < TL ? (row0 >> 11) : 16;
    const float* sh = modl + (size_t)b * NMODW + sidx * 1024; const float* scp = sh + 1024;
    const bool addp = pgate != nullptr && row0 >= TL;
    f32x4 xv[4][4]; float ss[4];
#pragma unroll
    for (int j = 0; j < 4; ++j)
#pragma unroll
      for (int i = 0; i < 4; ++i) xv[j][i] = *(const GAS f32x4*)(hp + (size_t)j * D + (i * 64 + lane) * 4);
    if (addp) {
      f32x4 pg[4], pc[4][4];
#pragma unroll
      for (int i = 0; i < 4; ++i) pg[i] = *(const GAS f32x4*)(pgate + (i * 64 + lane) * 4) * pcoef;
#pragma unroll
      for (int j = 0; j < 4; ++j)
#pragma unroll
        for (int i = 0; i < 4; ++i) pc[j][i] = *(const GAS f32x4*)(pctx + (size_t)(row0 + j - TL) * D + (i * 64 + lane) * 4);
#pragma unroll
      for (int j = 0; j < 4; ++j)
#pragma unroll
        for (int i = 0; i < 4; ++i) { xv[j][i] = xv[j][i] + pg[i] * pc[j][i]; *(GAS f32x4*)(hp + (size_t)j * D + (i * 64 + lane) * 4) = xv[j][i]; }
    }
#pragma unroll
    for (int j = 0; j < 4; ++j) { float t = 0.f;
#pragma unroll
      for (int i = 0; i < 4; ++i) t += xv[j][i][0] * xv[j][i][0] + xv[j][i][1] * xv[j][i][1] + xv[j][i][2] * xv[j][i][2] + xv[j][i][3] * xv[j][i][3];
      ss[j] = t; }
#pragma unroll
    for (int o = 1; o < 64; o <<= 1) {
#pragma unroll
      for (int j = 0; j < 4; ++j) ss[j] += __shfl_xor(ss[j], o); }
    f32x4 gsv[4], s0v[4];
#pragma unroll
    for (int i = 0; i < 4; ++i) { const int col = (i * 64 + lane) * 4; gsv[i] = gv[i] * (*(const GAS f32x4*)(scp + col) + 1.f); s0v[i] = *(const GAS f32x4*)(sh + col); }
#pragma unroll
    for (int i = 0; i < 4; ++i) { const int col = (i * 64 + lane) * 4;
#pragma unroll
      for (int j = 0; j < 4; ++j) st4(XN + (size_t)(row0 + j) * D + col, xv[j][i] * rsqrtf(ss[j] * (1.f / 1024.f) + EPS) * gsv[i] + s0v[i]); }
  }
}

DI void phase_attn(const Params& p, const int tid, LAS unsigned char* lds, int l, bool last) {
  unsigned char* ws = p.ws;
  const bf16_t* Qb = (const bf16_t*)(ws + OFF_Q); const bf16_t* Kb = (const bf16_t*)(ws + OFF_K); const bf16_t* Vb = (const bf16_t*)(ws + OFF_V);
  const bf16_t* SQ = (const bf16_t*)(ws + OFF_SQ); const bf16_t* SK = (const bf16_t*)(ws + OFF_SK); const bf16_t* SV = (const bf16_t*)(ws + OFF_SV);
  const float* ssq_q = (const float*)(ws + OFF_SSQ_Q); bf16_t* MIX = (bf16_t*)(ws + OFF_XN);
  const float LOG2E = 1.4426950408889634f;
  const int nitems = last ? 1536 : 1728;
  for (int it0 = blockIdx.x; it0 < nitems; it0 += gridDim.x) {
    int it = it0;
    if (gridDim.x == 256 && it0 < 1536) {
      const int c = blockIdx.x, xcd = c & 7, slot = c >> 3, rnd = it0 >> 8;
      it = (rnd < 4 ? 0 : 1024) + (((rnd & 3) * 32 + xcd * 4 + (slot >> 3)) << 3) + (slot & 7);
    }
    if (it < 1024 || (it >= 1536 && it < 1664)) {
      int b, h, q0, nt1;
      if (it < 1024) { b = it >> 6; h = (it >> 3) & 7; q0 = b * 2048 + (it & 7) * 256; nt1 = 16; }
      else { const int j = it - 1536; b = j >> 3; h = j & 7; q0 = TL + b * 256; nt1 = 0; }
      attn_item<96>(lds, tid, Qb + h * 96, 768, Kb + h * 96, 768, Vb + h * 64, 512, MIX + 256 + h * 64, 1024, q0, TL + b * 256, 2, b * 2048, nt1, false, 0, 0,
                    ssq_q + h * 2, 16, 0.10206207261596577f * LOG2E, -1e30f, 0.f);
    } else {
      int b, hq, q0, nt1, s1row, qpos0, kpos1;
      if (it < 1536) { const int j = it - 1024; b = j >> 5; hq = (j >> 3) & 3; const int qb = j & 7; qpos0 = qb * 256; q0 = b * 2048 + qpos0;
        const int st = qpos0 - 128 < 0 ? 0 : qpos0 - 128, en = qpos0 + 384 > 2048 ? 2048 : qpos0 + 384; kpos1 = st; s1row = b * 2048 + st; nt1 = (en - st) >> 7; }
      else { const int j = it - 1664; b = j >> 2; hq = j & 3; q0 = TL + b * 256; nt1 = 0; s1row = 0; qpos0 = 0; kpos1 = 0; }
      const int kvh = hq >> 1; const float sk = p.sink[l * 4 + hq] * LOG2E;
      attn_item<64>(lds, tid, SQ + hq * 64, 256, SK + kvh * 64, 128, SV + kvh * 64, 128, MIX + 768 + hq * 64, 1024, q0, TL + b * 256, 2, s1row, nt1, true, qpos0, kpos1,
                    nullptr, 0, LOG2E, sk, 1.f);
    }
  }
}

#define XB_TMO      128
#define XB_XCNT(j)  (256  + 64 * (j))
#define XB_XSUB(j)  (1280 + 64 * (j))
#define XB_XGEN(j)  (2304 + 64 * (j))
#define XB_TOP      3328
#define XB_TOPGEN   3392
#define XB_SPIN_CAP (1u << 22)
DI unsigned xb_ld(unsigned* p) { return __hip_atomic_load(p, __ATOMIC_RELAXED, __HIP_MEMORY_SCOPE_AGENT); }
DI unsigned xb_add(unsigned* p, unsigned v) { return __hip_atomic_fetch_add(p, v, __ATOMIC_RELAXED, __HIP_MEMORY_SCOPE_AGENT); }
DI unsigned xb_xcc_id() { return (unsigned)__builtin_amdgcn_s_getreg((3 << 11) | 20) & 0xFu; }
#define XB_SPIN(cond, bar) do { unsigned _sp = 0; while (cond) { __builtin_amdgcn_s_sleep(1); \
    if ((++_sp & 255u) == 0u) { if (xb_ld(&(bar)[XB_TMO])) break; if (_sp > XB_SPIN_CAP) { atomicAdd(&(bar)[XB_TMO], 1u); break; } } } } while (0)
DI void xcd_barrier_complete(unsigned* bar, unsigned x, unsigned& nloc, unsigned& nx) {
  const unsigned G = gridDim.x;
  unsigned sum, cnt, mine, sp = 0u;
  for (;;) {
    sum = 0u; cnt = 0u; mine = 0u;
#pragma unroll
    for (unsigned j = 0; j < 16; ++j) { const unsigned c = xb_ld(&bar[XB_XCNT(j)]); sum += c; cnt += (c > 0u) ? 1u : 0u; mine = (j == x) ? c : mine; }
    if (sum == G) break;
    __builtin_amdgcn_s_sleep(1);
    if ((++sp & 255u) == 0u) { if (xb_ld(&bar[XB_TMO])) break; if (sp > XB_SPIN_CAP) { atomicAdd(&bar[XB_TMO], 1u); break; } }
  }
  nloc = mine > 0u ? mine : 1u; nx = cnt > 0u ? cnt : 1u;
}
DI void xcd_barrier(unsigned* bar, volatile LAS unsigned* st) {
  asm volatile("s_waitcnt vmcnt(0)" ::: "memory");
  __syncthreads();
  if (threadIdx.x == 0) {
    const unsigned x = xb_xcc_id();
    __builtin_amdgcn_s_waitcnt(0);
    unsigned nloc = st[0], nx = st[1];
    if (nloc == 0u) { xcd_barrier_complete(bar, x, nloc, nx); st[0] = nloc; st[1] = nx; }
    const unsigned old = xb_add(&bar[XB_XSUB(x)], 1u);
    const unsigned gen = old / nloc;
    if (old + 1u == (gen + 1u) * nloc) {
      __builtin_amdgcn_fence(__ATOMIC_RELEASE, "agent");
      asm volatile("s_waitcnt vmcnt(0)" ::: "memory");
      const unsigned og = xb_add(&bar[XB_TOP], 1u);
      const unsigned tg = og / nx;
      if (og + 1u == (tg + 1u) * nx) xb_add(&bar[XB_TOPGEN], 1u);
      else XB_SPIN(xb_ld(&bar[XB_TOPGEN]) == tg, bar);
      __builtin_amdgcn_fence(__ATOMIC_ACQUIRE, "agent");
      xb_add(&bar[XB_XGEN(x)], 1u);
      asm volatile("s_waitcnt vmcnt(0)" ::: "memory");
    } else {
      XB_SPIN(xb_ld(&bar[XB_XGEN(x)]) == gen, bar);
      __builtin_amdgcn_fence(__ATOMIC_ACQUIRE, "agent");
      asm volatile("s_waitcnt vmcnt(0)" ::: "memory");
    }
  }
  __syncthreads();
}

#define PH_BEGIN() int tid = threadIdx.x; asm volatile("" : "+v"(tid)); unsigned char* ws_l_ = p.ws; asm volatile("" : "+s"(ws_l_)); unsigned char* ws = (unsigned char*)(GAS unsigned char*)ws_l_; Params q = p; q.ws = ws; \
  { float* o_ = p.out; asm volatile("" : "+s"(o_)); q.out = (float*)(GAS float*)o_; }
__global__ void __launch_bounds__(512, 2) mega(Params p) {
  extern __shared__ __attribute__((aligned(16))) unsigned char shm[];
  LAS unsigned char* lds = (LAS unsigned char*)shm;
  __builtin_assume(threadIdx.y == 0); __builtin_assume(threadIdx.z == 0);
  cg::grid_group grid = cg::this_grid();
  const int G = gridDim.x, bid = blockIdx.x;
  volatile LAS unsigned* xst = (volatile LAS unsigned*)(lds + 131072);
  { unsigned* bw = (unsigned*)(p.ws + OFF_BAR); for (int i = bid * 512 + (int)threadIdx.x; i < (int)(BAR_BYTES / 4); i += G * 512) bw[i] = 0u; }
  if (threadIdx.x == 0) { xst[0] = 0u; xst[1] = 0u; }
  __syncthreads();
  for (int rep = 0; rep < REP_PREP; ++rep) { phase_prep(p, lds); grid.sync(); }
  if (threadIdx.x == 0) (void)xb_add((unsigned*)(p.ws + OFF_BAR) + XB_XCNT(xb_xcc_id()), 1u);
#define GSYNC() do { unsigned char* wsb_ = p.ws; asm volatile("" : "+s"(wsb_)); xcd_barrier((unsigned*)(wsb_ + OFF_BAR), xst); } while (0)
#pragma unroll 1
  for (int step = 0; step < 12; ++step) {
    const int l = step / 3, kind = step % 3; const bool last = l == 3;
    const int nrows = (last && kind == 2) ? TL : T;
    { PH_BEGIN();
      const float* modl = (const float*)(ws + OFF_MOD) + (size_t)l * 17 * NMODW;
      const float* pgate = kind == 1 ? modl + (size_t)16 * NMODW + 2 * 1024 : kind == 2 ? modl + (size_t)16 * NMODW + 5 * 1024 : l > 0 ? modl - (size_t)NMODW + 8 * 1024 : nullptr;
      const float* hl0 = p.x; asm volatile("" : "+s"(hl0)); if (step != 0) hl0 = q.out;
      phase_norm(q, tid, hl0, (kind == 0 ? p.g_ffn1 : kind == 1 ? p.g_mix : p.g_ffn2) + l * D, modl, kind * 3, nrows, pgate, kind == 2 ? 1.f : 0.5f); }
    GSYNC();
    if (kind != 1) {
      { PH_BEGIN(); const unsigned char* wl = ws + OFF_W + (size_t)l * W_LAYER;
        EpiUp e{(bf16_t*)(ws + OFF_HID)}; run_gemm(lds, tid, (const bf16_t*)(ws + OFF_XN), (const bf16_t*)(wl + (kind == 0 ? WO_UP1 : WO_UP2)), nrows, 5632, 1024, e, G, bid); }
      GSYNC();
    } else {
      { PH_BEGIN(); const unsigned char* wl = ws + OFF_W + (size_t)l * W_LAYER;
        EpiZ e{(bf16_t*)(ws + OFF_ZTL), (bf16_t*)(ws + OFF_ZTC)}; run_gemm(lds, tid, (const bf16_t*)(wl + WO_AZ), (const bf16_t*)(ws + OFF_XN), 512, T, 1024, e, G, bid, 0, 0, 0, 1); }
      { PH_BEGIN(); const unsigned char* wl = ws + OFF_W + (size_t)l * W_LAYER;
        const float* cosS = (const float*)(ws + OFF_ROPE); const float* sinS = cosS + 2048 * 32; const float* cosM = sinS + 2048 * 32; const float* sinM = cosM + 2048 * 16;
        EpiInB e{(bf16_t*)(ws + OFF_LAT), (bf16_t*)(ws + OFF_SQ), (bf16_t*)(ws + OFF_SK), (bf16_t*)(ws + OFF_SV), (float*)(ws + OFF_KR), (float*)(ws + OFF_SSQ_CQ), (float*)(ws + OFF_SSQ_CKV),
                 (float*)(ws + OFF_SSQ_KR), p.g_swa_q + l * 64, p.g_swa_k + l * 64, p.g_mla_k + l * 96, cosS, sinS, cosM, sinM};
        run_gemm(lds, tid, (const bf16_t*)(ws + OFF_XN), (const bf16_t*)(wl + WO_INB), T, 1024, 1024, e, G, (bid + G - 32) % G); }
      GSYNC();
      { const int half = G >> 1;
        if (bid < half) { PH_BEGIN(); EpiFour e{(bf16_t*)(ws + OFF_XN), 0}; run_gemm(lds, tid, (const bf16_t*)(ws + OFF_DFTL), (const bf16_t*)(ws + OFF_ZTL), 2048, 4096, 4096, e, half, bid, 0, 0, 0, 1); }
        else {
#pragma unroll 1
          for (int pass = 0; pass < 2; ++pass) { PH_BEGIN(); const unsigned char* wl = ws + OFF_W + (size_t)l * W_LAYER;
            const float* cosM = (const float*)(ws + OFF_ROPE) + 2 * 2048 * 32; const float* sinM = cosM + 2048 * 16;
            EpiQKV e{(bf16_t*)(ws + OFF_Q), (bf16_t*)(ws + OFF_K), (bf16_t*)(ws + OFF_V), (const float*)(ws + OFF_KR), (const float*)(ws + OFF_SSQ_CQ), (const float*)(ws + OFF_SSQ_CKV),
                     (const float*)(ws + OFF_SSQ_KR), (float*)(ws + OFF_SSQ_Q), p.g_mla_q + l * 96, p.g_mla_k + l * 96, cosM, sinM, pass * 4};
            const int Gq = G - half, cq_ = bid - half, Kq = pass ? 128 : 256;
            run_gemm(lds, tid, (const bf16_t*)(ws + OFF_LAT) + pass * 256, (const bf16_t*)(wl + WO_QKV) + (size_t)pass * 1024 * 256, T, 1024, Kq, e, Gq, (cq_ + pass * (Gq >> 1)) % Gq, 0, 384, Kq); }
          if (!last) { PH_BEGIN(); EpiFour e2{(bf16_t*)(ws + OFF_XN), 1}; run_gemm(lds, tid, (const bf16_t*)(ws + OFF_DFTC), (const bf16_t*)(ws + OFF_ZTC), 256, 4096, 512, e2, G - half, bid - half, 0, 0, 0, 1); }
        } }
      GSYNC();
      { PH_BEGIN(); phase_attn(q, tid, lds, l, last); }
      GSYNC();
    }
#pragma unroll 1
    for (int pass = 0; pass < 2; ++pass) {
      if (pass == 1 && (bid >= 128 || (last && kind >= 1))) break;
      PH_BEGIN(); const unsigned char* wl = ws + OFF_W + (size_t)l * W_LAYER; const float* modl = (const float*)(ws + OFF_MOD) + (size_t)l * 17 * NMODW;
      const int Kf = kind == 1 ? 1024 : 2816, hf = bid >> 6;
      const bf16_t* Ar = kind == 1 ? (const bf16_t*)(ws + OFF_XN) : (const bf16_t*)(ws + OFF_HID);
      const bf16_t* Wr = (const bf16_t*)(wl + (kind == 0 ? WO_DN1 : kind == 1 ? WO_OUT : WO_DN2));
      const size_t koff = pass ? (size_t)hf * (Kf >> 1) : 0;
      const float* hs0 = p.x; asm volatile("" : "+s"(hs0)); if (step != 0) hs0 = q.out;
      EpiRes e{q.out, (float*)(ws + OFF_HCTX), modl + (kind * 3 + 2) * 1024, kind == 1 ? 1.f : 0.5f, (pass && hf) ? (float*)(ws + OFF_PCTX) : nullptr, hs0};
      run_gemm(lds, tid, Ar + koff, Wr + koff, pass ? TC : TL, 1024, pass ? (Kf >> 1) : Kf, e, pass ? 64 : G, pass ? (bid & 63) : bid, pass ? 128 : 0, Kf, Kf);
    }
    GSYNC();
  }
}

extern "C" void kernel_launch(void* const* d_in, const int* in_sizes, int n_in, void* d_out, int out_size, void* d_ws, size_t ws_size, hipStream_t stream) {
  (void)in_sizes; (void)n_in; (void)out_size;
  Params p{};
  const float** pp = (const float**)&p;
  for (int i = 0; i < 26; ++i) pp[i] = (const float*)d_in[i];
  p.out = (float*)d_out; p.ws = (unsigned char*)d_ws;
  static int grid_blocks = 0;
  if (!grid_blocks) {
    hipFuncSetAttribute((const void*)mega, hipFuncAttributeMaxDynamicSharedMemorySize, LDS_BYTES);
    int dev = 0, cus = 0, per_cu = 0;
    hipGetDevice(&dev);
    hipDeviceGetAttribute(&cus, hipDeviceAttributeMultiprocessorCount, dev);
    hipOccupancyMaxActiveBlocksPerMultiprocessor(&per_cu, mega, 512, LDS_BYTES);
    if (per_cu < 1) per_cu = 1;
    grid_blocks = cus;
    if (grid_blocks & 1) grid_blocks -= 1;
  }
  if (ws_size < WS_TOTAL) fprintf(stderr, "workspace too small: %zu < %zu\n", ws_size, (size_t)WS_TOTAL);
  void* args[] = {&p};
  hipError_t e = hipLaunchCooperativeKernel((void*)mega, dim3(grid_blocks), dim3(512), args, LDS_BYTES, stream);
  if (e != hipSuccess) fprintf(stderr, "cooperative launch failed: %s (grid %d)\n", hipGetErrorString(e), grid_blocks);
}
```
